# Optimizing an MI355X kernel written in HIP

```python
import jax, jax.numpy as jnp
from jax import lax
import numpy as np

D_MODEL = 4096
BATCH = 8
SEQ = 2048
DEPTH = 2

HEAD_DIM = 128
N_HEADS = D_MODEL // HEAD_DIM
N_KV_HEADS_B = max(1, N_HEADS // 4)
GROUP_B = N_HEADS // N_KV_HEADS_B
D_FF = ((8 * D_MODEL // 3 + 255) // 256) * 256
CONV_WIDTH = 3
BLOCK_Q = 128
N_A_LAYERS = DEPTH // 2
N_B_LAYERS = DEPTH - N_A_LAYERS
RMS_EPS = 1e-6

kernel_name = "yoco_stickbreak_fox_convglu"


def rms_norm(x, g):
    xf = x.astype(jnp.float32)
    y = xf * lax.rsqrt(jnp.mean(xf * xf, axis=-1, keepdims=True) + RMS_EPS)
    return (y * g.astype(jnp.float32)).astype(x.dtype)


def to_heads(t, n_heads):
    b, s, _ = t.shape
    return t.reshape(b, s, n_heads, HEAD_DIM).transpose(0, 2, 1, 3)


def merge_heads(t):
    b, n, s, dh = t.shape
    return t.transpose(0, 2, 1, 3).reshape(b, s, n * dh)


def stick_breaking_attention(q, k, v):
    seq = q.shape[2]
    scale = HEAD_DIM ** -0.5
    outs = []
    for i in range(seq // BLOCK_Q):
        q0 = i * BLOCK_Q
        kend = q0 + BLOCK_Q
        z = jnp.einsum('bhqd,bhkd->bhqk', q[:, :, q0:kend], k[:, :, :kend]).astype(jnp.float32) * scale
        t_pos = q0 + jnp.arange(BLOCK_Q)[:, None]
        s_pos = jnp.arange(kend)[None, :]
        strict = s_pos < t_pos
        log_1mb = jnp.where(strict, jax.nn.log_sigmoid(-z), 0.0)
        between = lax.cumsum(log_1mb, axis=3, reverse=True) - log_1mb
        w = jnp.where(strict, jnp.exp(jax.nn.log_sigmoid(z) + between), 0.0)
        outs.append(jnp.einsum('bhqk,bhkd->bhqd', w.astype(v.dtype), v[:, :, :kend]))
    return jnp.concatenate(outs, axis=2)


def forgetting_attention(q, k, v, c):
    seq = q.shape[3]
    scale = HEAD_DIM ** -0.5
    outs = []
    for i in range(seq // BLOCK_Q):
        q0 = i * BLOCK_Q
        kend = q0 + BLOCK_Q
        logits = jnp.einsum('bhgqd,bhkd->bhgqk', q[:, :, :, q0:kend], k[:, :, :kend]).astype(jnp.float32) * scale
        logits = logits + c[:, :, :, q0:kend, None] - c[:, :, :, None, :kend]
        t_pos = q0 + jnp.arange(BLOCK_Q)[:, None]
        s_pos = jnp.arange(kend)[None, :]
        logits = jnp.where(s_pos <= t_pos, logits, -jnp.inf)
        p = jax.nn.softmax(logits, axis=-1)
        outs.append(jnp.einsum('bhgqk,bhkd->bhgqd', p.astype(v.dtype), v[:, :, :kend]))
    return jnp.concatenate(outs, axis=3)


def conv_glu_ffn(xn, w_up, w_conv, b_conv, w_down):
    seq = xn.shape[1]
    gate, val = jnp.split(xn @ w_up, 2, axis=-1)
    gp = jnp.pad(gate, ((0, 0), (CONV_WIDTH - 1, 0), (0, 0)))
    conv = b_conv + sum(w_conv[j] * gp[:, j:j + seq] for j in range(CONV_WIDTH))
    return (jax.nn.silu(conv) * val) @ w_down


def setup_inputs(seed: int = 0) -> dict:
    key = jax.random.key(seed)
    ks = jax.random.split(key, 24)
    D, F = D_MODEL, D_FF
    kv_width = 2 * N_KV_HEADS_B * HEAD_DIM

    def nrm(k, shape, scale):
        return jax.random.normal(k, shape, jnp.float32) * scale

    def gain(k, shape):
        return 1.0 + 0.02 * jax.random.normal(k, shape, jnp.float32)

    nA, nB = N_A_LAYERS, N_B_LAYERS
    return {
        "x": nrm(ks[0], (BATCH, SEQ, D), 1.0),
        "a_attn_norm": gain(ks[1], (nA, D)),
        "a_w_qkv": nrm(ks[2], (nA, D, 3 * D), D ** -0.5),
        "a_w_o": nrm(ks[3], (nA, D, D), D ** -0.5),
        "a_ffn_norm": gain(ks[4], (nA, D)),
        "a_w_up": nrm(ks[5], (nA, D, 2 * F), D ** -0.5),
        "a_w_conv": nrm(ks[6], (nA, CONV_WIDTH, F), CONV_WIDTH ** -0.5),
        "a_b_conv": nrm(ks[7], (nA, F), 0.02),
        "a_w_down": nrm(ks[8], (nA, F, D), F ** -0.5),
        "kv_norm": gain(ks[9], (D,)),
        "w_kv": nrm(ks[10], (D, kv_width), D ** -0.5),
        "w_f": nrm(ks[11], (D, N_HEADS), 0.5 * D ** -0.5),
        "b_f": 3.0 + 0.5 * jax.random.normal(ks[12], (N_HEADS,), jnp.float32),
        "b_attn_norm": gain(ks[13], (nB, D)),
        "b_w_q": nrm(ks[14], (nB, D, D), D ** -0.5),
        "b_w_o": nrm(ks[15], (nB, D, D), D ** -0.5),
        "b_ffn_norm": gain(ks[16], (nB, D)),
        "b_w_up": nrm(ks[17], (nB, D, 2 * F), D ** -0.5),
        "b_w_conv": nrm(ks[18], (nB, CONV_WIDTH, F), CONV_WIDTH ** -0.5),
        "b_b_conv": nrm(ks[19], (nB, F), 0.02),
        "b_w_down": nrm(ks[20], (nB, F, D), F ** -0.5),
        "final_norm": gain(ks[21], (D,)),
    }


def reference(x, a_attn_norm, a_w_qkv, a_w_o, a_ffn_norm, a_w_up, a_w_conv, a_b_conv, a_w_down,
              kv_norm, w_kv, w_f, b_f,
              b_attn_norm, b_w_q, b_w_o, b_ffn_norm, b_w_up, b_w_conv, b_b_conv, b_w_down,
              final_norm):
    bsz, seq, _ = x.shape
    h = x
    for l in range(DEPTH):
        if l < N_A_LAYERS:
            i = l
            xn = rms_norm(h, a_attn_norm[i])
            q, k, v = jnp.split(xn @ a_w_qkv[i], 3, axis=-1)
            o = stick_breaking_attention(to_heads(q, N_HEADS), to_heads(k, N_HEADS), to_heads(v, N_HEADS))
            h = h + merge_heads(o) @ a_w_o[i]
            h = h + conv_glu_ffn(rms_norm(h, a_ffn_norm[i]), a_w_up[i], a_w_conv[i], a_b_conv[i], a_w_down[i])
        else:
            j = l - N_A_LAYERS
            if l == N_A_LAYERS:
                kv_in = rms_norm(h, kv_norm)
                k_s, v_s = jnp.split(kv_in @ w_kv, 2, axis=-1)
                k_s = to_heads(k_s, N_KV_HEADS_B)
                v_s = to_heads(v_s, N_KV_HEADS_B)
                log_f = jax.nn.log_sigmoid((kv_in @ w_f + b_f).astype(jnp.float32))
                c_s = jnp.cumsum(log_f, axis=1).transpose(0, 2, 1).reshape(bsz, N_KV_HEADS_B, GROUP_B, seq)
            xn = rms_norm(h, b_attn_norm[j])
            q = to_heads(xn @ b_w_q[j], N_HEADS).reshape(bsz, N_KV_HEADS_B, GROUP_B, seq, HEAD_DIM)
            o = forgetting_attention(q, k_s, v_s, c_s).reshape(bsz, N_HEADS, seq, HEAD_DIM)
            h = h + merge_heads(o) @ b_w_o[j]
            h = h + conv_glu_ffn(rms_norm(h, b_ffn_norm[j]), b_w_up[j], b_w_conv[j], b_b_conv[j], b_w_down[j])
    return rms_norm(h, final_norm)
```

```cpp
#include <hip/hip_runtime.h>
#include <cstdio>
#include <cstdint>
#include <type_traits>

#define LAS __attribute__((address_space(3)))
typedef unsigned short bf16_t;
typedef short bf16x8 __attribute__((ext_vector_type(8)));
typedef float f32x4 __attribute__((ext_vector_type(4)));
typedef float f32x16 __attribute__((ext_vector_type(16)));
typedef unsigned u32x4 __attribute__((ext_vector_type(4)));
typedef unsigned u32x2 __attribute__((ext_vector_type(2)));

#ifndef MK_N_LAUNCHES
#define MK_N_LAUNCHES 1
#endif

constexpr int DM = 4096, NB = 8, SEQ = 2048, MTOK = NB * SEQ, HD = 128, NH = 32, FF = 11008, FF2 = 2 * FF;
constexpr float RMS_EPS = 1e-6f;
constexpr float QSCALE = 0.08838834764831845f * 1.4426950408889634f;
constexpr float LOG2E = 1.4426950408889634f;
constexpr int NWAVES = 8;
constexpr int N_PHASES = 19;

constexpr size_t MiB = 1u << 20;
constexpr size_t WS_CTL = 0, CTL_ZERO_BYTES = 64 * 1024;
constexpr size_t WS_RSTDA = 1 * MiB;
constexpr size_t WS_RSTDF = WS_RSTDA + 64 * 1024;
constexpr size_t WS_WF = 2 * MiB;
constexpr size_t WS_FLOG = 3 * MiB;
constexpr size_t WS_C2 = 5 * MiB;
constexpr size_t WS_PART = 8 * MiB;
constexpr size_t WS_W = 16 * MiB;
constexpr size_t W_QKV = 0, W_O = 96 * MiB, W_UP = 128 * MiB, W_DOWN = 300 * MiB, W_END = 386 * MiB;
constexpr size_t WS_HB = WS_W + W_END;
constexpr size_t WS_R = WS_HB + 128 * MiB;
constexpr size_t R_QK = 0, R_VT = 256 * MiB, R_O = 384 * MiB, R_END = 512 * MiB;
constexpr size_t WS_ACT = WS_R + R_QK;
constexpr size_t WS_SIDE = WS_R + R_END;
constexpr size_t SIDE_ONE = (size_t)256 * 2 * 11008 * 4;
constexpr size_t WS_END = WS_SIDE + 66 * MiB;
constexpr int CONV_WGS = 48, CONV_D3 = 7424;
constexpr int CW_BAR = 1024;

constexpr int RING_BYTES = 131072, BGSCR_OFF = 81920  , LDSCTL_OFF = 155648, MISC_OFF = LDSCTL_OFF + 320, LDS_BYTES = 157696;

__device__ __forceinline__ unsigned cvt_pk_bf16(float lo, float hi) { unsigned r; asm volatile("v_cvt_pk_bf16_f32 %0, %1, %2" : "=v"(r) : "v"(lo), "v"(hi)); return r; }
__device__ __forceinline__ float bf2f(unsigned short b) { return __uint_as_float(((unsigned)b) << 16); }

namespace pg8 {
constexpr int BM = 256, BK = 64, HALF = 128, HTB = HALF * BK * 2, STAGE_BYTES = 8 * HTB, NXCD = 8, WGM = 8;
__host__ __device__ __forceinline__ int lds_byte(int r, int c) { const int st = (r >> 4) * 2 + (c >> 5), rr = r & 15, cc = c & 31, ob = rr * 64 + cc * 2; return st * 1024 + (ob ^ (((ob >> 9) & 1) << 5)); }
__host__ __device__ __forceinline__ void stage_rc(int b, int& R, int& C) { const int st = b / 1024, sb = b % 1024, swz = sb ^ (((sb >> 9) & 1) << 5); R = (st >> 1) * 16 + swz / 64; C = (st & 1) * 32 + (swz % 64) / 2; }
__host__ __device__ __forceinline__ int perm32(int rho) { const int n = rho >> 4, i = rho & 15; return 8 * (i >> 2) + 4 * n + (i & 3); }

struct Unit { int pm, pn; };
struct Gemm { const bf16_t* A; const bf16_t* Bt; int M, N, K; };

struct StaticOrder {
    int nM, nN, nwg, G, c, wgm;
    __host__ __device__ void init(int M, int N, int G_, int c_, int wgm_ = WGM) { nM = M / BM; nN = N / BM; nwg = nM * nN; G = G_; c = c_; wgm = wgm_; }
    __host__ __device__ bool next(int i, Unit& u) const {
        const long L = (long)i * G + c; if (L >= nwg) return false;
        int wgid = (int)L; { const int q = nwg / NXCD, r = nwg % NXCD, xcd = wgid % NXCD, off = wgid / NXCD; wgid = (xcd < r ? xcd * (q + 1) : r * (q + 1) + (xcd - r) * q) + off; }
        const int nig = wgm * nN, gid = wgid / nig, fm = gid * wgm, gsz = (nM - fm) < wgm ? (nM - fm) : wgm;
        u.pm = fm + ((wgid % nig) % gsz); u.pn = (wgid % nig) / gsz; return true;
    }
    __device__ __forceinline__ void a_ready(const Unit&) const {}
    __device__ __forceinline__ void done(const Unit&) const {}
};

struct FixedOrder {
    int nN, ppx, wpp, pm, slot;
    __host__ __device__ void init(int M, int N, int G, int c) { const int nM = M / BM; nN = N / BM; ppx = nM / NXCD; wpp = (G / NXCD) / ppx; const int x = c % NXCD, j = c / NXCD; pm = ppx * x + j % ppx; slot = j / ppx; }
    __host__ __device__ bool next(int i, Unit& u) const { if (wpp == 0 || slot >= wpp) return false; const int pn = slot + i * wpp; if (pn >= nN) return false; u.pm = pm; u.pn = pn; return true; }
    __device__ __forceinline__ void a_ready(const Unit&) const {}
    __device__ __forceinline__ void done(const Unit&) const {}
};

struct RowScale {
    const LAS float* tab;
    __device__ __forceinline__ void get8(int rbase, float (&sc)[2][4]) const {
        const unsigned a = (unsigned)(size_t)(tab + rbase);
        asm volatile("ds_read_b32 %0, %8\n\tds_read_b32 %1, %8 offset:64\n\tds_read_b32 %2, %8 offset:128\n\tds_read_b32 %3, %8 offset:192\n\t"
                     "ds_read_b32 %4, %8 offset:512\n\tds_read_b32 %5, %8 offset:576\n\tds_read_b32 %6, %8 offset:640\n\tds_read_b32 %7, %8 offset:704\n\ts_waitcnt lgkmcnt(0)"
                     : "=&v"(sc[0][0]), "=&v"(sc[0][1]), "=&v"(sc[0][2]), "=&v"(sc[0][3]), "=&v"(sc[1][0]), "=&v"(sc[1][1]), "=&v"(sc[1][2]), "=&v"(sc[1][3]) : "v"(a) : "memory");
    }
};
struct EpiRowScale {
    static constexpr bool PERM = true, AFTER_DRAIN = false;
    bf16_t* O; int ldc; RowScale rs; int qtiles; float qscale;
    __device__ __forceinline__ void operator()(const f32x4 (&acc)[2][2][4][2], const Unit& u, int wr, int wc, int fr, int fq) const {
        const int row0 = u.pm * BM + wr * 64 + fr, col0 = u.pn * BM + wc * 32 + 8 * fq;
        const float sc = (u.pn < qtiles) ? qscale : 1.f;
        float s8[2][4]; rs.get8(wr * 64 + fr, s8);
#pragma unroll
        for (int ai = 0; ai < 2; ++ai)
#pragma unroll
            for (int m = 0; m < 4; ++m) { const int row = row0 + ai * HALF + m * 16; const float s = s8[ai][m] * sc; bf16_t* rowp = O + (size_t)row * ldc + col0;
#pragma unroll
                for (int bj = 0; bj < 2; ++bj) { const f32x4 v0 = acc[ai][bj][m][0] * s, v1 = acc[ai][bj][m][1] * s;
                    u32x4 w; w.x = cvt_pk_bf16(v0[0], v0[1]); w.y = cvt_pk_bf16(v0[2], v0[3]); w.z = cvt_pk_bf16(v1[0], v1[1]); w.w = cvt_pk_bf16(v1[2], v1[3]);
                    *(u32x4*)(rowp + bj * HALF) = w; } }
    }
};
struct EpiColScale {
    static constexpr bool PERM = true, AFTER_DRAIN = false;
    bf16_t* O; int ldc; const float* cs;
    __device__ __forceinline__ void operator()(const f32x4 (&acc)[2][2][4][2], const Unit& u, int wr, int wc, int fr, int fq) const {
        const int row0 = u.pm * BM + wr * 64 + fr, col0 = u.pn * BM + wc * 32 + 8 * fq;
        f32x4 s[2][2];
#pragma unroll
        for (int bj = 0; bj < 2; ++bj) { s[bj][0] = *(const f32x4*)(cs + col0 + bj * HALF); s[bj][1] = *(const f32x4*)(cs + col0 + bj * HALF + 4); }
#pragma unroll
        for (int ai = 0; ai < 2; ++ai)
#pragma unroll
            for (int m = 0; m < 4; ++m) { const int row = row0 + ai * HALF + m * 16; bf16_t* rowp = O + (size_t)row * ldc + col0;
#pragma unroll
                for (int bj = 0; bj < 2; ++bj) { const f32x4 v0 = acc[ai][bj][m][0] * s[bj][0], v1 = acc[ai][bj][m][1] * s[bj][1];
                    u32x4 w; w.x = cvt_pk_bf16(v0[0], v0[1]); w.y = cvt_pk_bf16(v0[2], v0[3]); w.z = cvt_pk_bf16(v1[0], v1[1]); w.w = cvt_pk_bf16(v1[2], v1[3]);
                    *(u32x4*)(rowp + bj * HALF) = w; } }
    }
};
__device__ __forceinline__ float dpp_ror1(float v) { return __builtin_bit_cast(float, __builtin_amdgcn_update_dpp(__builtin_bit_cast(int, v), __builtin_bit_cast(int, v), 0x121, 0xf, 0xf, false)); }
__device__ __forceinline__ float dpp_ror2(float v) { return __builtin_bit_cast(float, __builtin_amdgcn_update_dpp(__builtin_bit_cast(int, v), __builtin_bit_cast(int, v), 0x122, 0xf, 0xf, false)); }
struct EpiGlu {
    static constexpr bool PERM = true, AFTER_DRAIN = false;
    bf16_t* act; RowScale rs; const float* wconv; const float* bconv; float* glast; float* pfirst; float* vfirst;
    __device__ __forceinline__ void operator()(const f32x4 (&acc)[2][2][4][2], const Unit& u, int wr, int wc, int fr, int fq) const {
        typedef float f32x2 __attribute__((ext_vector_type(2)));
        constexpr int FFc = 11008;
        const int f0 = u.pn * HALF + wc * 32 + 8 * fq;
        f32x2 w0[4], w1[4], w2[4], bb[4];
#pragma unroll
        for (int q = 0; q < 2; ++q) { const f32x4 a = *(const f32x4*)(wconv + f0 + 4 * q), b = *(const f32x4*)(wconv + FFc + f0 + 4 * q), c = *(const f32x4*)(wconv + 2 * FFc + f0 + 4 * q), d = *(const f32x4*)(bconv + f0 + 4 * q);
            w0[2 * q] = (f32x2){a[0], a[1]}; w0[2 * q + 1] = (f32x2){a[2], a[3]}; w1[2 * q] = (f32x2){b[0], b[1]}; w1[2 * q + 1] = (f32x2){b[2], b[3]};
            w2[2 * q] = (f32x2){c[0], c[1]}; w2[2 * q + 1] = (f32x2){c[2], c[3]}; bb[2 * q] = (f32x2){d[0], d[1]}; bb[2 * q + 1] = (f32x2){d[2], d[3]}; }
        const bool l15 = fr == 15, l14 = fr >= 14;
        float s8[2][4]; rs.get8(wr * 64 + fr, s8);
#pragma unroll
        for (int ai = 0; ai < 2; ++ai) {
            const int blk = u.pm * 4 + ai * 2 + wr;
            f32x2 gp[4];
#pragma unroll
            for (int q = 0; q < 4; ++q) gp[q] = (f32x2){0.f, 0.f};
#pragma unroll
            for (int m = 0; m < 4; ++m) {
                const int row = u.pm * BM + ai * HALF + wr * 64 + m * 16 + fr; const float s = s8[ai][m];
                f32x2 g[4], v[4], x1[4], x2[4], p1[4], p2[4], c[4], y[4];
#pragma unroll
                for (int q = 0; q < 4; ++q) { g[q] = (f32x2){acc[ai][0][m][q >> 1][2 * (q & 1)], acc[ai][0][m][q >> 1][2 * (q & 1) + 1]} * s; v[q] = (f32x2){acc[ai][1][m][q >> 1][2 * (q & 1)], acc[ai][1][m][q >> 1][2 * (q & 1) + 1]} * s; }
#pragma unroll
                for (int q = 0; q < 4; ++q) { x1[q].x = l15 ? gp[q].x : g[q].x; x1[q].y = l15 ? gp[q].y : g[q].y; x2[q].x = l14 ? gp[q].x : g[q].x; x2[q].y = l14 ? gp[q].y : g[q].y; }
#pragma unroll
                for (int q = 0; q < 4; ++q) { p1[q].x = dpp_ror1(x1[q].x); p1[q].y = dpp_ror1(x1[q].y); p2[q].x = dpp_ror2(x2[q].x); p2[q].y = dpp_ror2(x2[q].y); }
#pragma unroll
                for (int q = 0; q < 4; ++q) { c[q] = bb[q] + w0[q] * p2[q] + w1[q] * p1[q] + w2[q] * g[q];
                    const f32x2 t = c[q] * (-1.4426950408889634f); f32x2 e; e.x = __builtin_amdgcn_exp2f(t.x); e.y = __builtin_amdgcn_exp2f(t.y);
                    const f32x2 d = e + 1.f; f32x2 r; r.x = __builtin_amdgcn_rcpf(d.x); r.y = __builtin_amdgcn_rcpf(d.y);
                    y[q] = c[q] * r * v[q]; }
                u32x4 w; w.x = cvt_pk_bf16(y[0].x, y[0].y); w.y = cvt_pk_bf16(y[1].x, y[1].y); w.z = cvt_pk_bf16(y[2].x, y[2].y); w.w = cvt_pk_bf16(y[3].x, y[3].y);
                *(u32x4*)(act + (size_t)row * FFc + f0) = w;
                if (m == 0 && fr < 2) { float* pp = pfirst + ((size_t)blk * 2 + fr) * FFc + f0; float* vp = vfirst + ((size_t)blk * 2 + fr) * FFc + f0;
                    *(f32x4*)pp = (f32x4){c[0].x, c[0].y, c[1].x, c[1].y}; *(f32x4*)(pp + 4) = (f32x4){c[2].x, c[2].y, c[3].x, c[3].y};
                    *(f32x4*)vp = (f32x4){v[0].x, v[0].y, v[1].x, v[1].y}; *(f32x4*)(vp + 4) = (f32x4){v[2].x, v[2].y, v[3].x, v[3].y}; }
                if (m == 3 && fr >= 14) { float* gl = glast + ((size_t)blk * 2 + (fr - 14)) * FFc + f0;
                    *(f32x4*)gl = (f32x4){g[0].x, g[0].y, g[1].x, g[1].y}; *(f32x4*)(gl + 4) = (f32x4){g[2].x, g[2].y, g[3].x, g[3].y}; }
#pragma unroll
                for (int q = 0; q < 4; ++q) gp[q] = g[q];
            }
        }
    }
};
struct EpiResid {
    static constexpr bool PERM = true, AFTER_DRAIN = false;
    bf16_t* hb; float* part; int ldc;
    __device__ __forceinline__ void operator()(const f32x4 (&acc)[2][2][4][2], const Unit& u, int wr, int wc, int fr, int fq) const {
        const int row0 = u.pm * BM + wr * 64 + fr, col0 = u.pn * BM + wc * 32 + 8 * fq;
        u32x4 bs[2][4][2];
#pragma unroll
        for (int ai = 0; ai < 2; ++ai)
#pragma unroll
            for (int m = 0; m < 4; ++m)
#pragma unroll
                for (int bj = 0; bj < 2; ++bj) bs[ai][m][bj] = *(const u32x4*)(hb + (size_t)(row0 + ai * HALF + m * 16) * ldc + col0 + bj * HALF);
#pragma unroll
        for (int ai = 0; ai < 2; ++ai)
#pragma unroll
            for (int m = 0; m < 4; ++m) { const int row = row0 + ai * HALF + m * 16; const size_t off = (size_t)row * ldc + col0; float ss = 0.f;
#pragma unroll
                for (int bj = 0; bj < 2; ++bj) { const u32x4 b = bs[ai][m][bj];
                    f32x4 v0, v1;
                    v0[0] = acc[ai][bj][m][0][0] + __uint_as_float(b.x << 16); v0[1] = acc[ai][bj][m][0][1] + __uint_as_float(b.x & 0xffff0000u);
                    v0[2] = acc[ai][bj][m][0][2] + __uint_as_float(b.y << 16); v0[3] = acc[ai][bj][m][0][3] + __uint_as_float(b.y & 0xffff0000u);
                    v1[0] = acc[ai][bj][m][1][0] + __uint_as_float(b.z << 16); v1[1] = acc[ai][bj][m][1][1] + __uint_as_float(b.z & 0xffff0000u);
                    v1[2] = acc[ai][bj][m][1][2] + __uint_as_float(b.w << 16); v1[3] = acc[ai][bj][m][1][3] + __uint_as_float(b.w & 0xffff0000u);
                    u32x4 w; w.x = cvt_pk_bf16(v0[0], v0[1]); w.y = cvt_pk_bf16(v0[2], v0[3]); w.z = cvt_pk_bf16(v1[0], v1[1]); w.w = cvt_pk_bf16(v1[2], v1[3]);
                    *(u32x4*)(hb + off + bj * HALF) = w;
                    ss += (v0[0] * v0[0] + v0[1] * v0[1]) + (v0[2] * v0[2] + v0[3] * v0[3]) + (v1[0] * v1[0] + v1[1] * v1[1]) + (v1[2] * v1[2] + v1[3] * v1[3]); }
                ss += __shfl_xor(ss, 16); ss += __shfl_xor(ss, 32);
                if (fq == 0) part[(size_t)row * 64 + u.pn * 4 + wc] = ss; }
    }
};

template <class Epi, class Sched, bool ALIGN_EPI = false, bool SP2 = false>
__device__ __forceinline__ void gemm_phase(LAS unsigned char* lds, const Gemm g, const Sched& S, const Epi& E) {
    const int tid = threadIdx.x, wid = __builtin_amdgcn_readfirstlane(tid >> 6), lane = tid & 63, wr = wid >> 2, wc = wid & 3, fr = lane & 15, fq = lane >> 4;
    const int K = g.K, nt = K / BK;
    unsigned voffA[2], voffB[2];
#pragma unroll
    for (int i = 0; i < 2; ++i) { int R, C; stage_rc(tid * 16 + i * 8192, R, C); const int Rb = Epi::PERM ? ((R & ~31) + perm32(R & 31)) : R;
        voffA[i] = (unsigned)(R * K + C) * 2u; voffB[i] = (unsigned)(Rb * K + C) * 2u; }
    const unsigned kstep = (unsigned)(BK * 2);
    const unsigned hstep = (unsigned)HALF * (unsigned)K * 2u;
    const unsigned tstep = 2u * hstep;
    const __amdgpu_buffer_rsrc_t rsrcA = __builtin_amdgcn_make_buffer_rsrc((void*)g.A, 0, 0x7fffffff, 0x00020000), rsrcB = __builtin_amdgcn_make_buffer_rsrc((void*)g.Bt, 0, 0x7fffffff, 0x00020000);
    const unsigned ldsw = (unsigned)wid * 1024u;
    const int aoff = lds_byte(wr * 64 + fr, fq * 8), boff = lds_byte(wc * 32 + fr, fq * 8);
#define PG8_SA(b, h) (((b) * 2 + (h)) * HTB)
#define PG8_SB(b, h) ((4 + (b) * 2 + (h)) * HTB)
#define PG8_STAGE(bufoff, gbase, voff) do { _Pragma("unroll") for (int _i = 0; _i < 2; ++_i) \
        __builtin_amdgcn_raw_ptr_buffer_load_lds(PG8_RSRC_##voff, (LAS void*)(lds + (bufoff) + ldsw + _i * 8192), 16, (voff)[_i], (int)(gbase), 0, 0); } while (0)
#define PG8_RSRC_voffA rsrcA
#define PG8_RSRC_voffB rsrcB
#define PG8_LDA(dst, b, h) do { _Pragma("unroll") for (int m = 0; m < 4; ++m) _Pragma("unroll") for (int k = 0; k < 2; ++k) dst[m][k] = *(const LAS bf16x8*)(lds + PG8_SA(b, h) + aoff + m * 2048 + k * 1024); } while (0)
#define PG8_LDB(dst, b, h) do { _Pragma("unroll") for (int n = 0; n < 2; ++n) _Pragma("unroll") for (int k = 0; k < 2; ++k) dst[n][k] = *(const LAS bf16x8*)(lds + PG8_SB(b, h) + boff + n * 2048 + k * 1024); } while (0)
#define PG8_MMA(ai, bj, At, Bt) do { __builtin_amdgcn_s_setprio(1); _Pragma("unroll") for (int m = 0; m < 4; ++m) _Pragma("unroll") for (int n = 0; n < 2; ++n) _Pragma("unroll") for (int k = 0; k < 2; ++k) \
        acc[ai][bj][m][n] = __builtin_amdgcn_mfma_f32_16x16x32_bf16(Bt[n][k], At[m][k], acc[ai][bj][m][n], 0, 0, 0); __builtin_amdgcn_s_setprio(0); } while (0)
#define PG8_WAIT_V(n) asm volatile("s_waitcnt vmcnt(" #n ")" ::: "memory")
#define PG8_WAIT_L(n) asm volatile("s_waitcnt lgkmcnt(" #n ")" ::: "memory")
#define PG8_BAR __builtin_amdgcn_s_barrier()
#define PG8_SCHED __builtin_amdgcn_sched_barrier(0)
    Unit cur, nxt; int ui = 0;
    if (!S.next(0, cur)) return;
    f32x4 acc[2][2][4][2];
#pragma unroll
    for (int a = 0; a < 2; ++a)
#pragma unroll
        for (int b = 0; b < 2; ++b)
#pragma unroll
            for (int m = 0; m < 4; ++m)
#pragma unroll
                for (int n = 0; n < 2; ++n) acc[a][b][m][n] = (f32x4){0.f, 0.f, 0.f, 0.f};
    bf16x8 At[4][2], B0[2][2], B1[2][2];
    unsigned cA = (unsigned)cur.pm * tstep, cB = (unsigned)cur.pn * tstep;
    S.a_ready(cur);
    if constexpr (SP2) {
        PG8_STAGE(PG8_SB(0, 0), cB, voffB); PG8_STAGE(PG8_SB(0, 1), cB + hstep, voffB); PG8_STAGE(PG8_SA(0, 0), cA, voffA); PG8_STAGE(PG8_SA(0, 1), cA + hstep, voffA);
        if (wr == 1) PG8_BAR;
        PG8_WAIT_V(2); PG8_BAR;
        PG8_STAGE(PG8_SB(1, 0), cB + kstep, voffB); PG8_STAGE(PG8_SA(1, 0), cA + kstep, voffA); PG8_STAGE(PG8_SB(1, 1), cB + hstep + kstep, voffB);
        PG8_WAIT_V(6); PG8_BAR;
    } else {
        PG8_STAGE(PG8_SB(0, 0), cB, voffB); PG8_STAGE(PG8_SA(0, 0), cA, voffA); PG8_STAGE(PG8_SB(0, 1), cB + hstep, voffB); PG8_STAGE(PG8_SA(0, 1), cA + hstep, voffA);
        if (wr == 1) PG8_BAR;
        PG8_WAIT_V(4); PG8_BAR;
        PG8_STAGE(PG8_SB(1, 0), cB + kstep, voffB); PG8_STAGE(PG8_SA(1, 0), cA + kstep, voffA); PG8_STAGE(PG8_SB(1, 1), cB + hstep + kstep, voffB);
        PG8_WAIT_V(6); PG8_BAR;
    }
    for (;;) {
        const bool has_next = S.next(ui + 1, nxt);
        const unsigned nA = has_next ? (unsigned)nxt.pm * tstep : cA, nB = has_next ? (unsigned)nxt.pn * tstep : cB;
        for (int t = 0; t < nt; t += 2) {
            const bool last = (t == nt - 2);
            const unsigned a1 = cA + (unsigned)(t + 1) * kstep;
            const unsigned a2 = last ? nA : cA + (unsigned)(t + 2) * kstep, b2 = last ? nB : cB + (unsigned)(t + 2) * kstep;
            const unsigned a3 = a2 + kstep, b3 = b2 + kstep;
            if (last && has_next) S.a_ready(nxt);
            if constexpr (SP2) {
            PG8_LDB(B0, 0, 0); PG8_LDB(B1, 0, 1); PG8_SCHED; PG8_LDA(At, 0, 0); PG8_STAGE(PG8_SA(1, 1), a1 + hstep, voffA);
            PG8_WAIT_V(8); PG8_WAIT_L(0); PG8_BAR; PG8_MMA(0, 0, At, B0); PG8_MMA(0, 1, At, B1); PG8_BAR; PG8_SCHED;
            PG8_LDA(At, 0, 1); PG8_STAGE(PG8_SB(0, 0), b2, voffB); PG8_STAGE(PG8_SB(0, 1), b2 + hstep, voffB); PG8_STAGE(PG8_SA(0, 0), a2, voffA);
            PG8_WAIT_V(8); PG8_WAIT_L(0); PG8_BAR; PG8_MMA(1, 0, At, B0); PG8_MMA(1, 1, At, B1); PG8_BAR; PG8_SCHED;
            PG8_LDB(B0, 1, 0); PG8_LDB(B1, 1, 1); PG8_SCHED; PG8_LDA(At, 1, 0); PG8_STAGE(PG8_SA(0, 1), a2 + hstep, voffA);
            PG8_WAIT_V(8); PG8_WAIT_L(0); PG8_BAR; PG8_MMA(0, 0, At, B0); PG8_MMA(0, 1, At, B1); PG8_BAR; PG8_SCHED;
            PG8_LDA(At, 1, 1); PG8_STAGE(PG8_SB(1, 0), b3, voffB); PG8_STAGE(PG8_SB(1, 1), b3 + hstep, voffB); PG8_STAGE(PG8_SA(1, 0), a3, voffA);
            PG8_WAIT_V(8); PG8_WAIT_L(0); PG8_BAR; PG8_MMA(1, 0, At, B0); PG8_MMA(1, 1, At, B1); PG8_BAR; PG8_SCHED;
            } else {
            PG8_LDB(B0, 0, 0); PG8_SCHED; PG8_LDA(At, 0, 0); PG8_STAGE(PG8_SA(1, 1), a1 + hstep, voffA);
            PG8_WAIT_L(8); PG8_BAR; PG8_WAIT_L(0); PG8_MMA(0, 0, At, B0); PG8_BAR; PG8_SCHED;
            PG8_LDB(B1, 0, 1); PG8_STAGE(PG8_SB(0, 0), b2, voffB);
            PG8_BAR; PG8_WAIT_L(0); PG8_MMA(0, 1, At, B1); PG8_BAR;
            PG8_LDA(At, 0, 1); PG8_STAGE(PG8_SA(0, 0), a2, voffA);
            PG8_BAR; PG8_WAIT_L(0); PG8_MMA(1, 0, At, B0); PG8_BAR; PG8_SCHED;
            PG8_STAGE(PG8_SB(0, 1), b2 + hstep, voffB);
            PG8_WAIT_V(6); PG8_BAR; PG8_MMA(1, 1, At, B1); PG8_BAR;
            PG8_LDB(B0, 1, 0); PG8_SCHED; PG8_LDA(At, 1, 0); PG8_STAGE(PG8_SA(0, 1), a2 + hstep, voffA);
            PG8_WAIT_L(8); PG8_BAR; PG8_WAIT_L(0); PG8_MMA(0, 0, At, B0); PG8_BAR; PG8_SCHED;
            PG8_LDB(B1, 1, 1); PG8_STAGE(PG8_SB(1, 0), b3, voffB);
            PG8_BAR; PG8_WAIT_L(0); PG8_MMA(0, 1, At, B1); PG8_BAR;
            PG8_LDA(At, 1, 1); PG8_STAGE(PG8_SA(1, 0), a3, voffA);
            PG8_BAR; PG8_WAIT_L(0); PG8_MMA(1, 0, At, B0); PG8_BAR; PG8_SCHED;
            PG8_STAGE(PG8_SB(1, 1), b3 + hstep, voffB);
            PG8_WAIT_V(6); PG8_BAR; PG8_MMA(1, 1, At, B1); PG8_BAR;
            }
        }
        if constexpr (ALIGN_EPI) { if (wr == 0) PG8_BAR; }
        if constexpr (!Epi::AFTER_DRAIN) { E(acc, cur, wr, wc, fr, fq); S.done(cur); }
        if (!has_next) break;
#pragma unroll
        for (int a = 0; a < 2; ++a)
#pragma unroll
            for (int b = 0; b < 2; ++b)
#pragma unroll
                for (int m = 0; m < 4; ++m)
#pragma unroll
                    for (int n = 0; n < 2; ++n) acc[a][b][m][n] = (f32x4){0.f, 0.f, 0.f, 0.f};
        cur = nxt; cA = nA; cB = nB; ++ui;
        if constexpr (ALIGN_EPI) { if (wr == 1) PG8_BAR; }
    }
    PG8_WAIT_V(0);
    if constexpr (!ALIGN_EPI) { if (wr == 0) PG8_BAR; }
    PG8_BAR;
#undef PG8_SA
#undef PG8_SB
#undef PG8_STAGE
#undef PG8_RSRC_voffA
#undef PG8_RSRC_voffB
#undef PG8_LDA
#undef PG8_LDB
#undef PG8_MMA
#undef PG8_WAIT_V
#undef PG8_WAIT_L
#undef PG8_BAR
#undef PG8_SCHED
}
}
#define PG8_SP2 true
#define PG8_ALIGN true
constexpr int RSTAB_OFF = LDSCTL_OFF + 1024;
__device__ __forceinline__ pg8::RowScale make_rowscale(LAS unsigned char* lds, const pg8::FixedOrder& S, const float* rstd, const float* part) {
    LAS float* tab = (LAS float*)(lds + RSTAB_OFF);
    if (threadIdx.x < 256) { const int row = S.pm * 256 + threadIdx.x; float v;
        if (rstd) v = rstd[row];
        else { const f32x4* pp = (const f32x4*)(part + (size_t)row * 64); float s = 0.f;
#pragma unroll
            for (int j = 0; j < 16; ++j) { const f32x4 q = pp[j]; s += (q[0] + q[1]) + (q[2] + q[3]); }
            v = 1.f / sqrtf(s * (1.f / 4096.f) + 1e-6f); }
        tab[threadIdx.x] = v; }
    __syncthreads();
    return pg8::RowScale{tab};
}

#define XB_TMO      128
#define XB_XCNT(j)  (256  + 64 * (j))
#define XB_XSUB(j)  (1280 + 64 * (j))
#define XB_XGEN(j)  (2304 + 64 * (j))
#define XB_TOP      3328
#define XB_TOPGEN   3392
#define XCD_BAR_WORDS 3456
#define XB_SPIN_CAP (1u << 18)
__device__ __forceinline__ unsigned xb_ld(unsigned* p)              { return __hip_atomic_load(p, __ATOMIC_RELAXED, __HIP_MEMORY_SCOPE_AGENT); }
__device__ __forceinline__ unsigned xb_add(unsigned* p, unsigned v) { return __hip_atomic_fetch_add(p, v, __ATOMIC_RELAXED, __HIP_MEMORY_SCOPE_AGENT); }
__device__ __forceinline__ unsigned xb_xcc_id() { return (unsigned)__builtin_amdgcn_s_getreg((3 << 11) | 20) & 0xFu; }
#define XB_SPIN(cond, bar) do { unsigned _sp = 0; while (cond) { __builtin_amdgcn_s_sleep(1); \
    if ((++_sp & 255u) == 0u) { if (xb_ld(&(bar)[XB_TMO])) break; if (_sp > XB_SPIN_CAP) { atomicAdd(&(bar)[XB_TMO], 1u); break; } } } } while (0)
__device__ unsigned g_ctl[XCD_BAR_WORDS + 64];
#define XB_EXIT (XCD_BAR_WORDS + 32)
struct XcdBarrier { unsigned* bar; unsigned x; volatile LAS unsigned* st; };
__device__ __forceinline__ XcdBarrier xcd_barrier_post(unsigned* bar, volatile LAS unsigned* st) {
    XcdBarrier b; b.bar = bar; b.x = xb_xcc_id(); b.st = st;
    if (threadIdx.x == 0) (void)xb_add(&bar[XB_XCNT(b.x)], 1u);
    return b;
}
__device__ __forceinline__ void xcd_barrier_complete(unsigned* bar, unsigned x, unsigned& nloc, unsigned& nx) {
    const unsigned G = gridDim.x * gridDim.y * gridDim.z;
    unsigned sum, cnt, mine, sp = 0u;
    for (;;) {
        sum = 0u; cnt = 0u; mine = 0u;
#pragma unroll
        for (unsigned j = 0; j < 16; ++j) { const unsigned c = xb_ld(&bar[XB_XCNT(j)]); sum += c; cnt += (c > 0u) ? 1u : 0u; mine = (j == x) ? c : mine; }
        if (sum == G) break;
        __builtin_amdgcn_s_sleep(1);
        if ((++sp & 255u) == 0u) { if (xb_ld(&bar[XB_TMO])) break; if (sp > XB_SPIN_CAP) { atomicAdd(&bar[XB_TMO], 1u); break; } }
    }
    nloc = mine > 0u ? mine : 1u; nx = cnt > 0u ? cnt : 1u;
}
__device__ __forceinline__ void xcd_barrier(const XcdBarrier& b) {
    asm volatile("s_waitcnt vmcnt(0)" ::: "memory");
    __syncthreads();
    if (threadIdx.x == 0) {
        unsigned* bar = b.bar;
        __builtin_amdgcn_s_waitcnt(0);
        unsigned nloc = b.st[0], nx = b.st[1];
        if (nloc == 0u) { xcd_barrier_complete(bar, b.x, nloc, nx); b.st[0] = nloc; b.st[1] = nx; }
        const unsigned old = xb_add(&bar[XB_XSUB(b.x)], 1u);
        const unsigned gen = old / nloc;
        if (old + 1u == (gen + 1u) * nloc) {
            __builtin_amdgcn_fence(__ATOMIC_RELEASE, "agent");
            asm volatile("s_waitcnt vmcnt(0)" ::: "memory");
            const unsigned og = xb_add(&bar[XB_TOP], 1u);
            const unsigned tg = og / nx;
            if (og + 1u == (tg + 1u) * nx) xb_add(&bar[XB_TOPGEN], 1u);
            else XB_SPIN(xb_ld(&bar[XB_TOPGEN]) == tg, bar);
            __builtin_amdgcn_fence(__ATOMIC_ACQUIRE, "agent");
            xb_add(&bar[XB_XGEN(b.x)], 1u);
            asm volatile("s_waitcnt vmcnt(0)" ::: "memory");
        } else {
            XB_SPIN(xb_ld(&bar[XB_XGEN(b.x)]) == gen, bar);
            __builtin_amdgcn_fence(__ATOMIC_ACQUIRE, "agent");
            asm volatile("s_waitcnt vmcnt(0)" ::: "memory");
        }
    }
    __syncthreads();
}

__device__ __forceinline__ float wave_sum(float v) {
#pragma unroll
    for (int o = 1; o < 64; o <<= 1) v += __shfl_xor(v, o);
    return v;
}
__device__ __forceinline__ float rdlane(float v, int l) { return __builtin_bit_cast(float, __builtin_amdgcn_readlane(__builtin_bit_cast(int, v), l)); }

struct CvtJob { const float* W; const float* g; bf16_t* out; int K, N; int glu; };
__device__ __forceinline__ void cvt_load(const CvtJob& jb, int item, int lane, float (&v)[64], float& gv) {
    const int nblk = jb.N >> 6; const int kb = item / nblk, nb = item - kb * nblk; const int k0 = kb * 64, n0 = nb * 64;
    gv = jb.g ? jb.g[k0 + lane] : 1.f;
    const unsigned long long src = (unsigned long long)(jb.W + (size_t)k0 * jb.N + n0);
#pragma unroll
    for (int kk = 0; kk < 64; ++kk) { const unsigned long long rp = src + (unsigned long long)kk * (unsigned long long)jb.N * 4ull;
        const unsigned lo = (unsigned)__builtin_amdgcn_readfirstlane((int)(unsigned)rp), hi = (unsigned)__builtin_amdgcn_readfirstlane((int)(unsigned)(rp >> 32));
        v[kk] = ((const __attribute__((address_space(1))) float*)(((unsigned long long)hi << 32) | lo))[(unsigned)lane]; }
}
__device__ __forceinline__ void cvt_store(const CvtJob& jb, int item, int lane, const float (&v)[64], float gv, LAS unsigned char* scr) {
    const int nblk = jb.N >> 6; const int kb = item / nblk, nb = item - kb * nblk; const int k0 = kb * 64, n0 = nb * 64;
    int nrow0 = n0;
    if (jb.glu) { const int isv = n0 >= FF ? 1 : 0, f = n0 - isv * FF; nrow0 = 256 * (f >> 7) + 128 * isv + (f & 127); }
    if (jb.g) {
#pragma unroll
    for (int c = 0; c < 8; ++c) { u32x4 o;
        o.x = cvt_pk_bf16(v[8 * c + 0] * rdlane(gv, 8 * c + 0), v[8 * c + 1] * rdlane(gv, 8 * c + 1));
        o.y = cvt_pk_bf16(v[8 * c + 2] * rdlane(gv, 8 * c + 2), v[8 * c + 3] * rdlane(gv, 8 * c + 3));
        o.z = cvt_pk_bf16(v[8 * c + 4] * rdlane(gv, 8 * c + 4), v[8 * c + 5] * rdlane(gv, 8 * c + 5));
        o.w = cvt_pk_bf16(v[8 * c + 6] * rdlane(gv, 8 * c + 6), v[8 * c + 7] * rdlane(gv, 8 * c + 7));
        *(LAS u32x4*)(scr + lane * 144 + 16 * c) = o; }
    } else {
#pragma unroll
    for (int c = 0; c < 8; ++c) { u32x4 o;
        o.x = cvt_pk_bf16(v[8 * c + 0], v[8 * c + 1]); o.y = cvt_pk_bf16(v[8 * c + 2], v[8 * c + 3]); o.z = cvt_pk_bf16(v[8 * c + 4], v[8 * c + 5]); o.w = cvt_pk_bf16(v[8 * c + 6], v[8 * c + 7]);
        *(LAS u32x4*)(scr + lane * 144 + 16 * c) = o; }
    }
    const int r = lane >> 3, cc = lane & 7;
    bf16_t* dst = jb.out + (size_t)(nrow0 + r) * jb.K + k0 + 8 * cc;
#pragma unroll
    for (int i = 0; i < 8; ++i) { const u32x4 o = *(const LAS u32x4*)(scr + (8 * i + r) * 144 + 16 * cc); *(u32x4*)(dst + (size_t)(8 * i) * jb.K) = o; }
}
#define CVT_PIPE1(JB, first, end, stride, SCR) do { int r_ = (first); const int e_ = (end), t_ = (stride); if (r_ < e_) { float va_[64], vb_[64], ga_, gb_; cvt_load(JB, r_, lane, va_, ga_); \
        for (;;) { int nx_ = r_ + t_; cvt_load(JB, nx_ < e_ ? nx_ : r_, lane, vb_, gb_); cvt_store(JB, r_, lane, va_, ga_, SCR); r_ = nx_; if (r_ >= e_) break; \
                   nx_ = r_ + t_; cvt_load(JB, nx_ < e_ ? nx_ : r_, lane, va_, ga_); cvt_store(JB, r_, lane, vb_, gb_, SCR); r_ = nx_; if (r_ >= e_) break; } } } while (0)
#define CVT_WINDOW(JB, B, n, lo, hi, w, T, SCR) do { int g0_ = (lo) + (w); if (g0_ < (B)) g0_ += (((B) - g0_ + (T) - 1) / (T)) * (T); const int eg_ = (hi) < (B) + (n) ? (hi) : (B) + (n); \
        CVT_PIPE1(JB, g0_ - (B), eg_ - (B), T, SCR); } while (0)
typedef float f32x2 __attribute__((ext_vector_type(2)));
__device__ __forceinline__ void cvt_item2(const CvtJob& jb, int item, int lane, LAS unsigned char* scr) {
    const int nblk = jb.N >> 7; const int kb = item / nblk, nb = item - kb * nblk; const int k0 = kb * 64, n0 = nb * 128;
    const float gv = jb.g ? jb.g[k0 + lane] : 1.f;
    const unsigned long long src = (unsigned long long)(jb.W + (size_t)k0 * jb.N + n0);
    f32x2 v[64];
#pragma unroll
    for (int kk = 0; kk < 64; ++kk) { const unsigned long long rp = src + (unsigned long long)kk * (unsigned long long)jb.N * 4ull;
        const unsigned lo = (unsigned)__builtin_amdgcn_readfirstlane((int)(unsigned)rp), hi = (unsigned)__builtin_amdgcn_readfirstlane((int)(unsigned)(rp >> 32));
        v[kk] = ((const __attribute__((address_space(1))) f32x2*)(((unsigned long long)hi << 32) | lo))[(unsigned)lane]; }
    int nrow0 = n0;
    if (jb.glu) { const int isv = n0 >= FF ? 1 : 0, f = n0 - isv * FF; nrow0 = 256 * (f >> 7) + 128 * isv + (f & 127); }
    if (jb.g) {
#pragma unroll
        for (int e = 0; e < 2; ++e)
#pragma unroll
            for (int c = 0; c < 8; ++c) { u32x4 o;
                o.x = cvt_pk_bf16(v[8 * c + 0][e] * rdlane(gv, 8 * c + 0), v[8 * c + 1][e] * rdlane(gv, 8 * c + 1)); o.y = cvt_pk_bf16(v[8 * c + 2][e] * rdlane(gv, 8 * c + 2), v[8 * c + 3][e] * rdlane(gv, 8 * c + 3));
                o.z = cvt_pk_bf16(v[8 * c + 4][e] * rdlane(gv, 8 * c + 4), v[8 * c + 5][e] * rdlane(gv, 8 * c + 5)); o.w = cvt_pk_bf16(v[8 * c + 6][e] * rdlane(gv, 8 * c + 6), v[8 * c + 7][e] * rdlane(gv, 8 * c + 7));
                *(LAS u32x4*)(scr + (2 * lane + e) * 144 + 16 * c) = o; }
    } else {
#pragma unroll
        for (int e = 0; e < 2; ++e)
#pragma unroll
            for (int c = 0; c < 8; ++c) { u32x4 o;
                o.x = cvt_pk_bf16(v[8 * c + 0][e], v[8 * c + 1][e]); o.y = cvt_pk_bf16(v[8 * c + 2][e], v[8 * c + 3][e]); o.z = cvt_pk_bf16(v[8 * c + 4][e], v[8 * c + 5][e]); o.w = cvt_pk_bf16(v[8 * c + 6][e], v[8 * c + 7][e]);
                *(LAS u32x4*)(scr + (2 * lane + e) * 144 + 16 * c) = o; }
    }
    const int r = lane >> 3, cc = lane & 7;
    bf16_t* dst = jb.out + (size_t)(nrow0 + r) * jb.K + k0 + 8 * cc;
#pragma unroll
    for (int i = 0; i < 16; ++i) { const u32x4 o = *(const LAS u32x4*)(scr + (8 * i + r) * 144 + 16 * cc); __builtin_nontemporal_store(o, (u32x4*)(dst + (size_t)(8 * i) * jb.K)); }
}
#define CVT_NITEMS(K, N) (((K) >> 6) * ((N) >> 6))
#define CVT_NITEMS2(K, N) (((K) >> 6) * ((N) >> 7))

template <int R>
struct BgCvt {
    CvtJob j0, j1, j2; int n0, n1, n2;
    int first, stride;
    __device__ __forceinline__ bool active(int item) const { return item < n0 + n1 + n2; }
    __device__ __forceinline__ static void loc1(const CvtJob& jb, int r, int step, const float*& src, const float*& gp, bf16_t*& dst, int& N, int& K) {
        N = jb.N; K = jb.K; const int nblk = N >> 6, kb = r / nblk, nb = r - kb * nblk, k0 = kb * 64 + R * step, n0c = nb * 64;
        int nrow0 = n0c; if (jb.glu) { const int isv = n0c >= FF ? 1 : 0, f = n0c - isv * FF; nrow0 = 256 * (f >> 7) + 128 * isv + (f & 127); }
        src = jb.W + (size_t)k0 * N + n0c; gp = jb.g ? jb.g + k0 : nullptr; dst = jb.out + (size_t)nrow0 * K + k0;
    }
    __device__ __forceinline__ void locate(int item, int step, const float*& src, const float*& gp, bf16_t*& dst, int& N, int& K) const {
        if (item < n0) loc1(j0, item, step, src, gp, dst, N, K);
        else if (item < n0 + n1) loc1(j1, item - n0, step, src, gp, dst, N, K);
        else loc1(j2, item - n0 - n1, step, src, gp, dst, N, K);
    }
    __device__ __forceinline__ void issue(int item, int step, float (&cv)[R], float& gv, int lane) const {
        const float* src; const float* gp; bf16_t* dst; int N, K; locate(item, step, src, gp, dst, N, K);
        gv = gp ? gp[lane & (R - 1)] : 1.f;
#pragma unroll
        for (int i = 0; i < R; ++i) cv[i] = src[(size_t)i * N + lane];
    }
    __device__ __forceinline__ void finish(int& item, int& step, const float (&cv)[R], float gv, int lane, LAS unsigned char* scr) const {
        const float* src; const float* gp; bf16_t* dst; int N, K; locate(item, 0, src, gp, dst, N, K);
#pragma unroll
        for (int q = 0; q < R / 8; ++q) { u32x4 o;
            o.x = cvt_pk_bf16(cv[8 * q + 0] * rdlane(gv, 8 * q + 0), cv[8 * q + 1] * rdlane(gv, 8 * q + 1)); o.y = cvt_pk_bf16(cv[8 * q + 2] * rdlane(gv, 8 * q + 2), cv[8 * q + 3] * rdlane(gv, 8 * q + 3));
            o.z = cvt_pk_bf16(cv[8 * q + 4] * rdlane(gv, 8 * q + 4), cv[8 * q + 5] * rdlane(gv, 8 * q + 5)); o.w = cvt_pk_bf16(cv[8 * q + 6] * rdlane(gv, 8 * q + 6), cv[8 * q + 7] * rdlane(gv, 8 * q + 7));
            *(LAS u32x4*)(scr + lane * 144 + step * (2 * R) + 16 * q) = o; }
        if (++step == 64 / R) {
            const int r = lane >> 3, cc = lane & 7; bf16_t* d = dst + (size_t)r * K + 8 * cc;
#pragma unroll
            for (int i = 0; i < 8; ++i) { const u32x4 o = *(const LAS u32x4*)(scr + (8 * i + r) * 144 + 16 * cc); __builtin_nontemporal_store(o, (u32x4*)(d + (size_t)(8 * i) * K)); }
            step = 0; item += stride; }
    }
};

__device__ __forceinline__ int rho32(int m) { return (m & 0x13) | ((m & 4) << 1) | ((m & 8) >> 1); }
constexpr int ATT_K0 = 0, ATT_V0 = 32768, ATT_C2 = 65536, ATT_FLAG = 73728;

template <bool FOX>
__device__ __forceinline__ void attn_phase(LAS unsigned char* lds, const bf16_t* qk, int ldqk, int kcol0, int hshift, const bf16_t* vT, const float* c2g, bf16_t* o, int G, int wg, const BgCvt<FOX ? 8 : 16> bg) {
    const int tid = threadIdx.x, lane = tid & 63, w = __builtin_amdgcn_readfirstlane(tid >> 6), n = lane & 31, hi = lane >> 5;
    constexpr int BGR = FOX ? 8 : 16; int bgi = bg.first, bgs = 0;
    float cv[BGR], cgv = 1.f; bool bga = false;
    if constexpr (!FOX) { bga = bg.active(bgi); if (bga) bg.issue(bgi, bgs, cv, cgv, lane); }
    const int krow = tid >> 4, kch = tid & 15, vrow = tid >> 3, vch = tid & 7;
    const int kst0 = krow * 256 + ((kch ^ (krow & 15)) << 4), kst1 = (krow + 32) * 256 + ((kch ^ ((krow + 32) & 15)) << 4);
    const int vst0 = vrow * 128 + ((vch ^ ((vrow >> 1) & 7)) << 4), vst1 = (vrow + 64) * 128 + ((vch ^ (((vrow + 64) >> 1) & 7)) << 4);
    const int rK = rho32(n), kx = rK & 15, vx = (rK >> 1) & 7;
    int koff[8], voff[4];
#pragma unroll
    for (int kk = 0; kk < 8; ++kk) koff[kk] = rK * 256 + (((2 * kk + hi) ^ kx) << 4);
#pragma unroll
    for (int c = 0; c < 4; ++c) voff[c] = rK * 128 + (((2 * c + hi) ^ vx) << 4);

#define ATT_SCHED __builtin_amdgcn_sched_barrier(0)
#define ATT_VLOAD(dst, Vb_, c) do { _Pragma("unroll") for (int d = 0; d < 4; ++d) dst[d] = *(const LAS bf16x8*)((Vb_) + d * 4096 + voff[c]); } while (0)
#define ATT_VMMA(src, P_) do { _Pragma("unroll") for (int d = 0; d < 4; ++d) O[d] = __builtin_amdgcn_mfma_f32_32x32x16_bf16(src[d], (P_), O[d], 0, 0, 0); } while (0)
    bf16x8 qf[8]; u32x4 sk0, sk1, sv0, sv1; int bh_lds = -1;
#define ATT_COORD(uu, bh_, qb_) int bh_ = (uu) & 255; const int qb_ = (uu) >> 8; if (FOX) { const int x_ = bh_ & 7, sl_ = bh_ >> 3, gq_ = sl_ & 3, gi_ = (sl_ >> 2) * 8 + x_; bh_ = (gi_ >> 3) * 32 + (gi_ & 7) * 4 + gq_; }
#define ATT_PREFETCH(uu) do { ATT_COORD(uu, pbh, pqb) const int pb = pbh >> 5, ph = pbh & 31, pkv = ph >> hshift; \
        const bf16_t* qp_ = qk + ((size_t)pb * SEQ + pqb * 256 + 32 * w + n) * ldqk + ph * HD + 8 * hi; \
        _Pragma("unroll") for (int kk = 0; kk < 8; ++kk) qf[kk] = *(const bf16x8*)(qp_ + 16 * kk); \
        const bf16_t* kp_ = qk + ((size_t)pb * SEQ + krow + 64 * (4 * pqb + 3)) * ldqk + kcol0 + pkv * HD + kch * 8; sk0 = *(const u32x4*)kp_; sk1 = *(const u32x4*)(kp_ + (size_t)32 * ldqk); \
        const bf16_t* vp_ = vT + ((size_t)pkv * HD + vrow) * MTOK + (size_t)pb * SEQ + vch * 8 + 64 * (4 * pqb + 3); sv0 = *(const u32x4*)vp_; sv1 = *(const u32x4*)(vp_ + (size_t)64 * MTOK); } while (0)
    auto unit_at = [&](int r) -> int { if (!FOX) { const int uu = wg + G * r; return uu < NB * NH * 8 ? uu : -1; }
        const int v = r * G + ((r & 1) ? G - 1 - wg : wg); return v < NB * NH * 8 ? (((7 - (v >> 8)) << 8) | (v & 255)) : -1; };
    int urnd = 0, u = unit_at(0);
    if (u >= 0) ATT_PREFETCH(u);
    for (; u >= 0; ) {
        const int unext = unit_at(++urnd);
        ATT_COORD(u, bh, qblk)
        const int b = bh >> 5, h = bh & 31, kvh = h >> hshift;
        const int t0 = qblk * 256 + 32 * w, t = t0 + n;
        const size_t tok = (size_t)b * SEQ + t;
        const bf16_t* kg = qk + ((size_t)b * SEQ + krow) * ldqk + kcol0 + kvh * HD + kch * 8;
        const bf16_t* vg = vT + ((size_t)kvh * HD + vrow) * MTOK + (size_t)b * SEQ + vch * 8;
        if (FOX) { if (bh != bh_lds) { *(LAS f32x4*)(lds + ATT_C2 + tid * 16) = *(const f32x4*)(c2g + (size_t)bh * SEQ + tid * 4); bh_lds = bh; } }
        int j = 4 * qblk + 3;
#define ATT_LOAD(jj) do { const bf16_t* kp_ = kg + (size_t)(64 * (jj)) * ldqk; sk0 = *(const u32x4*)kp_; sk1 = *(const u32x4*)(kp_ + (size_t)32 * ldqk); \
        const bf16_t* vp_ = vg + 64 * (jj); sv0 = *(const u32x4*)vp_; sv1 = *(const u32x4*)(vp_ + (size_t)64 * MTOK); } while (0)
#define ATT_STORE(bb) do { *(LAS u32x4*)(lds + ATT_K0 + (bb) * 16384 + kst0) = sk0; *(LAS u32x4*)(lds + ATT_K0 + (bb) * 16384 + kst1) = sk1; \
        *(LAS u32x4*)(lds + ATT_V0 + (bb) * 16384 + vst0) = sv0; *(LAS u32x4*)(lds + ATT_V0 + (bb) * 16384 + vst1) = sv1; } while (0)
        ATT_STORE(0);
        __syncthreads();
        f32x16 O[4];
#pragma unroll
        for (int d = 0; d < 4; ++d)
#pragma unroll
            for (int r = 0; r < 16; ++r) O[d][r] = 0.f;
        float R = FOX ? 0.f : 1.f, m_run = -1e30f, l_run = 0.f;
        int cur = 0;
        const int jw = 4 * qblk + (w >> 1);
        bool wdone = false;
        for (; j >= 0; --j) {
            if (j > 0) ATT_LOAD(j - 1);
            if (j <= jw && !wdone) {
                const LAS unsigned char* Kb = lds + ATT_K0 + cur * 16384;
                const LAS unsigned char* Vb = lds + ATT_V0 + cur * 16384;
                const bool need_mask = (64 * j + 63 >= t0);
                if (!FOX) {
                    bf16x8 ka[4], kc[4], va[4], vb[4];
#define ATT_KLOAD1(dst, kb_, q) do { _Pragma("unroll") for (int i_ = 0; i_ < 4; ++i_) dst[i_] = *(const LAS bf16x8*)(Kb + (kb_) * 8192 + koff[4 * (q) + i_]); } while (0)
#define ATT_KMMA1(src, q) do { _Pragma("unroll") for (int i_ = 0; i_ < 4; ++i_) S = __builtin_amdgcn_mfma_f32_32x32x16_bf16(src[i_], qf[4 * (q) + i_], S, 0, 0, 0); } while (0)
#pragma unroll
                    for (int kb = 1; kb >= 0; --kb) {
                        ATT_KLOAD1(ka, kb, 0); ATT_KLOAD1(kc, kb, 1);
                        f32x16 S;
#pragma unroll
                        for (int r = 0; r < 16; ++r) S[r] = 0.f;
                        ATT_SCHED;
                        ATT_KMMA1(ka, 0); ATT_KMMA1(kc, 1);
                        ATT_SCHED;
                        const int keybase = 64 * j + 32 * kb + 8 * hi;
                        float uu[16], sg[16], E[16], wv[16];
#pragma unroll
                        for (int r = 0; r < 16; ++r) { const float e = __builtin_amdgcn_exp2f(S[r]); const float u1 = __builtin_amdgcn_rcpf(1.f + e); uu[r] = u1; sg[r] = 1.f - u1; }
                        if (need_mask) {
#pragma unroll
                            for (int r = 0; r < 16; ++r) { const int key = keybase + 16 * (r >> 3) + (r & 7); if (key >= t) { uu[r] = 1.f; sg[r] = 0.f; } }
                        }
                        float run = 1.f;
#pragma unroll
                        for (int i = 7; i >= 0; --i) { E[i] = run; run *= uu[i]; }
                        const float tot0 = run; run = 1.f;
#pragma unroll
                        for (int i = 7; i >= 0; --i) { E[8 + i] = run; run *= uu[8 + i]; }
                        const float tot1 = run;
                        const float p0 = __shfl_xor(tot0, 32), p1 = __shfl_xor(tot1, 32);
                        ATT_SCHED;
                        ATT_VLOAD(va, Vb, 2 * kb); ATT_VLOAD(vb, Vb, 2 * kb + 1);
                        ATT_SCHED;
                        const float off1 = hi ? 1.f : p1;
                        const float off0 = tot1 * p1 * (hi ? 1.f : p0);
                        const float b0 = off0 * R, b1 = off1 * R;
#pragma unroll
                        for (int r = 0; r < 16; ++r) wv[r] = sg[r] * E[r] * (r < 8 ? b0 : b1);
                        R *= (tot0 * tot1) * (p0 * p1);
                        union { u32x4 u; bf16x8 v; } pf0, pf1;
                        pf0.u.x = cvt_pk_bf16(wv[0], wv[1]); pf0.u.y = cvt_pk_bf16(wv[2], wv[3]); pf0.u.z = cvt_pk_bf16(wv[4], wv[5]); pf0.u.w = cvt_pk_bf16(wv[6], wv[7]);
                        pf1.u.x = cvt_pk_bf16(wv[8], wv[9]); pf1.u.y = cvt_pk_bf16(wv[10], wv[11]); pf1.u.z = cvt_pk_bf16(wv[12], wv[13]); pf1.u.w = cvt_pk_bf16(wv[14], wv[15]);
                        ATT_SCHED;
                        ATT_VMMA(va, pf0.v); ATT_VMMA(vb, pf1.v);
                        ATT_SCHED;
                    }
#undef ATT_KLOAD1
#undef ATT_KMMA1
                } else {
                    f32x16 S[2];
                    const LAS float* c2s = (const LAS float*)(lds + ATT_C2);
#pragma unroll
                    for (int kb = 0; kb < 2; ++kb)
#pragma unroll
                        for (int a = 0; a < 2; ++a) { const int kbase = 64 * j + 32 * kb + 16 * a + 8 * hi; const f32x4 c0 = *(const LAS f32x4*)(c2s + kbase), c1 = *(const LAS f32x4*)(c2s + kbase + 4);
                            S[kb][8 * a + 0] = c0[0]; S[kb][8 * a + 1] = c0[1]; S[kb][8 * a + 2] = c0[2]; S[kb][8 * a + 3] = c0[3];
                            S[kb][8 * a + 4] = c1[0]; S[kb][8 * a + 5] = c1[1]; S[kb][8 * a + 6] = c1[2]; S[kb][8 * a + 7] = c1[3]; }
                    bf16x8 ka[4], kc[4], va[4], vb[4];
#define ATT_KLOAD2(dst, q) do { dst[0] = *(const LAS bf16x8*)(Kb + koff[2 * (q)]); dst[1] = *(const LAS bf16x8*)(Kb + 8192 + koff[2 * (q)]); \
        dst[2] = *(const LAS bf16x8*)(Kb + koff[2 * (q) + 1]); dst[3] = *(const LAS bf16x8*)(Kb + 8192 + koff[2 * (q) + 1]); } while (0)
#define ATT_KMMA2(src, q) do { S[0] = __builtin_amdgcn_mfma_f32_32x32x16_bf16(src[0], qf[2 * (q)], S[0], 0, 0, 0); S[1] = __builtin_amdgcn_mfma_f32_32x32x16_bf16(src[1], qf[2 * (q)], S[1], 0, 0, 0); \
        S[0] = __builtin_amdgcn_mfma_f32_32x32x16_bf16(src[2], qf[2 * (q) + 1], S[0], 0, 0, 0); S[1] = __builtin_amdgcn_mfma_f32_32x32x16_bf16(src[3], qf[2 * (q) + 1], S[1], 0, 0, 0); } while (0)
                    ATT_KLOAD2(ka, 0); ATT_KLOAD2(kc, 1);
                    ATT_SCHED;

                    ATT_KMMA2(ka, 0); ATT_SCHED; ATT_KLOAD2(ka, 2); ATT_SCHED; ATT_KMMA2(kc, 1); ATT_SCHED; ATT_KLOAD2(kc, 3); ATT_SCHED; ATT_KMMA2(ka, 2); ATT_SCHED;
                    ATT_VLOAD(va, Vb, 0); ATT_VLOAD(vb, Vb, 1);
                    ATT_SCHED; ATT_KMMA2(kc, 3);

                    ATT_SCHED;
#undef ATT_KLOAD2
#undef ATT_KMMA2
                    if (need_mask) {
#pragma unroll
                        for (int kb = 0; kb < 2; ++kb)
#pragma unroll
                            for (int r = 0; r < 16; ++r) { const int key = 64 * j + 32 * kb + 8 * hi + 16 * (r >> 3) + (r & 7); if (key > t) S[kb][r] = -__builtin_inff(); }
                    }
                    float mx = S[0][0];
#pragma unroll
                    for (int kb = 0; kb < 2; ++kb)
#pragma unroll
                        for (int r = 0; r < 16; ++r) mx = __builtin_fmaxf(mx, S[kb][r]);
                    mx = __builtin_fmaxf(mx, __shfl_xor(mx, 32));
                    if (__any(mx > m_run)) {
                        const float m_new = __builtin_fmaxf(m_run, mx); const float alpha = __builtin_amdgcn_exp2f(m_run - m_new);
#pragma unroll
                        for (int d = 0; d < 4; ++d)
#pragma unroll
                            for (int r = 0; r < 16; ++r) O[d][r] *= alpha;
                        l_run *= alpha; m_run = m_new;
                    }
                    float ps = 0.f;
#pragma unroll
                    for (int kb = 0; kb < 2; ++kb)
#pragma unroll
                        for (int r = 0; r < 16; ++r) { S[kb][r] = __builtin_amdgcn_exp2f(S[kb][r] - m_run); ps += S[kb][r]; }
                    l_run += ps;
                    union { u32x4 u; bf16x8 v; } pf[4];
#pragma unroll
                    for (int kb = 0; kb < 2; ++kb)
#pragma unroll
                        for (int ks = 0; ks < 2; ++ks) {
                            pf[2 * kb + ks].u.x = cvt_pk_bf16(S[kb][8 * ks + 0], S[kb][8 * ks + 1]); pf[2 * kb + ks].u.y = cvt_pk_bf16(S[kb][8 * ks + 2], S[kb][8 * ks + 3]);
                            pf[2 * kb + ks].u.z = cvt_pk_bf16(S[kb][8 * ks + 4], S[kb][8 * ks + 5]); pf[2 * kb + ks].u.w = cvt_pk_bf16(S[kb][8 * ks + 6], S[kb][8 * ks + 7]);
                        }
                    ATT_SCHED;

                    ATT_VMMA(va, pf[0].v); ATT_SCHED; ATT_VLOAD(va, Vb, 2); ATT_SCHED; ATT_VMMA(vb, pf[1].v); ATT_SCHED; ATT_VLOAD(vb, Vb, 3); ATT_SCHED; ATT_VMMA(va, pf[2].v); ATT_SCHED; ATT_VMMA(vb, pf[3].v);

                    ATT_SCHED;
                }
            }
            if (!FOX) {
                wdone = wdone || __all(R < 1.17549435e-38f);
                if (lane == 0) *(volatile LAS unsigned*)(lds + ATT_FLAG + 32 * cur + 4 * w) = wdone ? 1u : 0u;
            }
            if constexpr (!FOX) {
                if (bga) bg.finish(bgi, bgs, cv, cgv, lane, lds + BGSCR_OFF + w * 9216);
                bga = bg.active(bgi);
            }
            if (j > 0) ATT_STORE(cur ^ 1);
            if constexpr (!FOX) {
                if (bga) bg.issue(bgi, bgs, cv, cgv, lane);
            }
            __syncthreads();
            if (!FOX) {
                const volatile LAS unsigned* fl = (const volatile LAS unsigned*)(lds + ATT_FLAG + 32 * cur);
                const unsigned alld = fl[0] & fl[1] & fl[2] & fl[3] & fl[4] & fl[5] & fl[6] & fl[7];
                if (alld) break;
            }
            cur ^= 1;
        }
#undef ATT_LOAD
        if (unext >= 0) ATT_PREFETCH(unext);
        float inv = 1.f;
        if (FOX) { const float lt = l_run + __shfl_xor(l_run, 32); inv = 1.f / lt; }
        bf16_t* op = o + tok * DM + h * HD + 8 * hi;
#pragma unroll
        for (int d = 0; d < 4; ++d)
#pragma unroll
            for (int a = 0; a < 2; ++a) { u32x4 wv4;
                wv4.x = cvt_pk_bf16(O[d][8 * a + 0] * inv, O[d][8 * a + 1] * inv); wv4.y = cvt_pk_bf16(O[d][8 * a + 2] * inv, O[d][8 * a + 3] * inv);
                wv4.z = cvt_pk_bf16(O[d][8 * a + 4] * inv, O[d][8 * a + 5] * inv); wv4.w = cvt_pk_bf16(O[d][8 * a + 6] * inv, O[d][8 * a + 7] * inv);
                *(u32x4*)(op + 32 * d + 16 * a) = wv4; }
        u = unext;
    }
#undef ATT_STORE
#undef ATT_SCHED
#undef ATT_VLOAD
#undef ATT_VMMA
#undef ATT_COORD
#undef ATT_PREFETCH
    if constexpr (!FOX) {
        while (bga) { bg.finish(bgi, bgs, cv, cgv, lane, lds + BGSCR_OFF + w * 9216); bga = bg.active(bgi); if (bga) bg.issue(bgi, bgs, cv, cgv, lane); } }
}

__device__ __forceinline__ void flogit_phase(LAS unsigned char* lds, const bf16_t* hb, const bf16_t* wf_t, const float* rstd, const float* b_f, float* flog, int G, int wg) {
    const int tid = threadIdx.x, lane = tid & 63, w = __builtin_amdgcn_readfirstlane(tid >> 6), n = lane & 31, hi = lane >> 5;
    const int rsub = w & 1, kq = w >> 1;
    LAS float* red = (LAS float*)lds;
    for (int rb = wg; rb < MTOK / 64; rb += G) {
        const int row0 = rb * 64 + rsub * 32;
        const bf16_t* ap = hb + (size_t)(row0 + n) * DM + kq * 1024 + 32 * hi;
        const bf16_t* bp = wf_t + (size_t)n * DM + kq * 1024 + 32 * hi;
        f32x16 acc;
#pragma unroll
        for (int r = 0; r < 16; ++r) acc[r] = 0.f;
#pragma unroll 2
        for (int g = 0; g < 16; ++g) {
            bf16x8 a[4], bb[4];
#pragma unroll
            for (int i = 0; i < 4; ++i) { a[i] = *(const bf16x8*)(ap + g * 64 + 8 * i); bb[i] = *(const bf16x8*)(bp + g * 64 + 8 * i); }
#pragma unroll
            for (int i = 0; i < 4; ++i) acc = __builtin_amdgcn_mfma_f32_32x32x16_bf16(a[i], bb[i], acc, 0, 0, 0);
        }
#pragma unroll
        for (int r = 0; r < 16; ++r) red[(w * 16 + r) * 64 + lane] = acc[r];
        __syncthreads();
        if (kq == 0) {
            const float bias = b_f[n];
#pragma unroll
            for (int r = 0; r < 16; ++r) {
                float s = 0.f;
#pragma unroll
                for (int q = 0; q < 4; ++q) s += red[((q * 2 + rsub) * 16 + r) * 64 + lane];
                const int row = row0 + (r & 3) + 8 * (r >> 2) + 4 * hi;
                const float v = rstd[row] * s + bias;
                const float ls = __builtin_fminf(v, 0.f) - log1pf(__expf(-__builtin_fabsf(v)));
                flog[(size_t)row * NH + n] = ls;
            }
        }
        __syncthreads();
    }
}
__device__ __forceinline__ void cumsum_phase(LAS unsigned char* lds, const float* flog, float* c2, int G, int wg) {
    const int tid = threadIdx.x, lane = tid & 63, w = tid >> 6;
    LAS float* wt = (LAS float*)lds;
    for (int bh = wg; bh < NB * NH; bh += G) {
        const int b = bh >> 5, h = bh & 31;
        float v[4];
#pragma unroll
        for (int k = 0; k < 4; ++k) v[k] = flog[((size_t)b * SEQ + 4 * tid + k) * NH + h];
        v[1] += v[0]; v[2] += v[1]; v[3] += v[2];
        float s = v[3];
#pragma unroll
        for (int o = 1; o < 64; o <<= 1) { const float tv = __shfl_up(s, o); if (lane >= o) s += tv; }
        if (lane == 63) wt[w] = s;
        __syncthreads();
        float base = s - v[3];
        for (int i = 0; i < w; ++i) base += wt[i];
        f32x4 ov; ov[0] = (base + v[0]) * -LOG2E; ov[1] = (base + v[1]) * -LOG2E; ov[2] = (base + v[2]) * -LOG2E; ov[3] = (base + v[3]) * -LOG2E;
        *(f32x4*)(c2 + (size_t)bh * SEQ + 4 * tid) = ov;
        __syncthreads();
    }
}

__device__ __forceinline__ void unpack8(const u32x4 p, float (&f)[8]) {
    f[0] = __uint_as_float(p.x << 16); f[1] = __uint_as_float(p.x & 0xffff0000u); f[2] = __uint_as_float(p.y << 16); f[3] = __uint_as_float(p.y & 0xffff0000u);
    f[4] = __uint_as_float(p.z << 16); f[5] = __uint_as_float(p.z & 0xffff0000u); f[6] = __uint_as_float(p.w << 16); f[7] = __uint_as_float(p.w & 0xffff0000u);
}
__device__ __forceinline__ void convfix_phase(const float* glast, const float* pfirst, const float* vfirst, const float* wconv, bf16_t* act, int G, int wg) {
    constexpr int NCG = FF / 8, NBLK = MTOK / 64, NTASK = NBLK * NCG;
    const int gt = wg * (NWAVES * 64) + threadIdx.x, stride = G * NWAVES * 64;
    for (int task = gt; task < NTASK; task += stride) {
        const int blk = task / NCG, cg = task - blk * NCG, f0 = cg * 8;
        if ((blk & (SEQ / 64 - 1)) == 0) continue;
        const float* g0p = glast + ((size_t)(blk - 1) * 2 + 0) * FF + f0; const float* g1p = g0p + FF;
        const float* p0p = pfirst + ((size_t)blk * 2 + 0) * FF + f0; const float* p1p = p0p + FF;
        const float* v0p = vfirst + ((size_t)blk * 2 + 0) * FF + f0; const float* v1p = v0p + FF;
        float y0[8], y1[8];
#pragma unroll
        for (int q = 0; q < 2; ++q) {
            const f32x4 w0 = *(const f32x4*)(wconv + f0 + 4 * q), w1 = *(const f32x4*)(wconv + FF + f0 + 4 * q);
            const f32x4 G0 = *(const f32x4*)(g0p + 4 * q), G1 = *(const f32x4*)(g1p + 4 * q), P0 = *(const f32x4*)(p0p + 4 * q), P1 = *(const f32x4*)(p1p + 4 * q), V0 = *(const f32x4*)(v0p + 4 * q), V1 = *(const f32x4*)(v1p + 4 * q);
#pragma unroll
            for (int i = 0; i < 4; ++i) { const float c0 = P0[i] + w0[i] * G0[i] + w1[i] * G1[i], c1 = P1[i] + w0[i] * G1[i];
                y0[4 * q + i] = c0 / (1.f + __expf(-c0)) * V0[i]; y1[4 * q + i] = c1 / (1.f + __expf(-c1)) * V1[i]; }
        }
        u32x4 o0, o1; o0.x = cvt_pk_bf16(y0[0], y0[1]); o0.y = cvt_pk_bf16(y0[2], y0[3]); o0.z = cvt_pk_bf16(y0[4], y0[5]); o0.w = cvt_pk_bf16(y0[6], y0[7]);
        o1.x = cvt_pk_bf16(y1[0], y1[1]); o1.y = cvt_pk_bf16(y1[2], y1[3]); o1.z = cvt_pk_bf16(y1[4], y1[5]); o1.w = cvt_pk_bf16(y1[6], y1[7]);
        *(u32x4*)(act + (size_t)(blk * 64) * FF + f0) = o0; *(u32x4*)(act + (size_t)(blk * 64 + 1) * FF + f0) = o1;
    }
}

struct Args { const float* in[22]; float* out; unsigned char* ws; int ph_lo, ph_hi; };
__global__ void __launch_bounds__(NWAVES * 64, 2) yoco_fwd(Args args) {
    extern __shared__ __attribute__((aligned(16))) unsigned char lds_raw[];
    LAS unsigned char* lds = (LAS unsigned char*)lds_raw;
    volatile LAS unsigned* MISC = (volatile LAS unsigned*)(lds + MISC_OFF);
    const int tid = threadIdx.x, lane = tid & 63, wave = __builtin_amdgcn_readfirstlane(tid >> 6);
    const int G = gridDim.x, wg = blockIdx.x;
    const int gw = wg * NWAVES + wave, NGW = G * NWAVES;
    unsigned char* ws = args.ws;
    for (int u = tid; u < (LDS_BYTES - LDSCTL_OFF) / 4; u += NWAVES * 64) ((LAS unsigned*)(lds + LDSCTL_OFF))[u] = 0u;
    __syncthreads();
    XcdBarrier bar; bar.bar = g_ctl; bar.x = 0; bar.st = nullptr;
    if (MK_N_LAUNCHES == 1) bar = xcd_barrier_post(g_ctl, MISC + 8);
    const int lo = args.ph_lo, hi = args.ph_hi;
#define IN(k) (lo <= (k) && (k) < hi)
#define SEAM(k) do { if (MK_N_LAUNCHES == 1 && IN(k) && IN((k) + 1)) xcd_barrier(bar); } while (0)

    float* hres = args.out;
    float* rstdA = (float*)(ws + WS_RSTDA);
    bf16_t* wf_t = (bf16_t*)(ws + WS_WF); float* flog = (float*)(ws + WS_FLOG); float* c2 = (float*)(ws + WS_C2); float* part = (float*)(ws + WS_PART);
    bf16_t* Wqkv_t = (bf16_t*)(ws + WS_W + W_QKV); bf16_t* Wo_t = (bf16_t*)(ws + WS_W + W_O); bf16_t* Wup_t = (bf16_t*)(ws + WS_W + W_UP); bf16_t* Wdown_t = (bf16_t*)(ws + WS_W + W_DOWN);
    bf16_t* hb = (bf16_t*)(ws + WS_HB); bf16_t* qkb = (bf16_t*)(ws + WS_R + R_QK); bf16_t* vTb = (bf16_t*)(ws + WS_R + R_VT); bf16_t* ob = (bf16_t*)(ws + WS_R + R_O);
    const CvtJob jB0{args.in[14], args.in[13], Wqkv_t, DM, DM, 0}, jB1{args.in[10], args.in[9], Wqkv_t + (size_t)DM * DM, DM, 2048, 0}, jB2{args.in[15], nullptr, Wo_t, DM, DM, 0},
                 jB3{args.in[17], args.in[16], Wup_t, DM, FF2, 1}, jB4{args.in[20], nullptr, Wdown_t, FF, DM, 0};
    constexpr int nB0 = CVT_NITEMS(DM, DM), nB1 = CVT_NITEMS(DM, 2048), nB2 = CVT_NITEMS(DM, DM), nB3 = CVT_NITEMS(DM, FF2), nB4 = CVT_NITEMS(FF, DM), nBd = nB2 + nB3 + nB4;
    const int conv_wgs = (G >= 128 && G % 8 == 0) ? CONV_WGS : 0, conv_d3 = conv_wgs ? CONV_D3 : 0;
    const int conv_wgs_unused_ = 0;
    bf16_t* actb = (bf16_t*)(ws + WS_ACT); float* glast = (float*)(ws + WS_SIDE); float* pfirst = (float*)(ws + WS_SIDE + SIDE_ONE); float* vfirst = (float*)(ws + WS_SIDE + 2 * SIDE_ONE);

    auto layer = [&](auto LC) __attribute__((always_inline)) {
        constexpr int l = decltype(LC)::value;
        constexpr int P = 9 * l;
        constexpr int nkv = l ? 1024 : 4096;
        if (IN(P + 0)) {
            LAS unsigned char* cscr = lds + wave * 18432;
            if (l == 0) {
                const CvtJob j0{args.in[2], args.in[1], Wqkv_t, DM, 3 * DM, 0};
                CVT_PIPE1(j0, gw, CVT_NITEMS(DM, 3 * DM), NGW, cscr);
            } else {
                CVT_WINDOW(jB0, 0, nB0, 0, nB0 + nB1 + nB2, gw, NGW, cscr); CVT_WINDOW(jB1, nB0, nB1, 0, nB0 + nB1 + nB2, gw, NGW, cscr); CVT_WINDOW(jB2, nB0 + nB1, nB2, 0, nB0 + nB1 + nB2, gw, NGW, cscr);
                { constexpr int m3 = CVT_NITEMS2(DM, FF2), m4 = CVT_NITEMS2(FF, DM);
                  for (int it = conv_d3 + gw; it < m3 + (conv_wgs ? 0 : m4); it += NGW) {
                      if (it < m3) { cvt_item2(jB3, it, lane, lds + wave * 18432); asm volatile("; job B3"); } else { cvt_item2(jB4, it - m3, lane, lds + wave * 18432); asm volatile("; job B4"); } } }
            }
            if (l == 0) {
                const float* x = args.in[0];
                for (int m = gw; m < MTOK; m += NGW) {
                    const f32x4* xr = (const f32x4*)(x + (size_t)m * DM) + lane; f32x4 v[16]; float s = 0.f;
#pragma unroll
                    for (int j = 0; j < 16; ++j) { v[j] = xr[64 * j]; s += (v[j][0] * v[j][0] + v[j][1] * v[j][1]) + (v[j][2] * v[j][2] + v[j][3] * v[j][3]); }
                    s = wave_sum(s);
                    if (lane == 0) rstdA[m] = 1.f / sqrtf(s * (1.f / DM) + RMS_EPS);
                    u32x2* o8 = (u32x2*)(hb + (size_t)m * DM) + lane;
#pragma unroll
                    for (int j = 0; j < 16; ++j) { u32x2 p; p.x = cvt_pk_bf16(v[j][0], v[j][1]); p.y = cvt_pk_bf16(v[j][2], v[j][3]); o8[64 * j] = p; }
                }
            } else {
                const float* wf = args.in[11]; const float* gk = args.in[9];
                for (int i = wg * NWAVES * 64 + tid; i < NH * DM; i += G * NWAVES * 64) { const int hh = i / DM, k = i - hh * DM; wf_t[i] = (bf16_t)(cvt_pk_bf16(wf[(size_t)k * NH + hh] * gk[k], 0.f) & 0xffffu); }
                for (int r = wg * NWAVES * 64 + tid; r < MTOK; r += G * NWAVES * 64) { const f32x4* pp = (const f32x4*)(part + (size_t)r * 64); float s = 0.f;
#pragma unroll
                    for (int j = 0; j < 16; ++j) { const f32x4 q = pp[j]; s += (q[0] + q[1]) + (q[2] + q[3]); }
                    rstdA[r] = 1.f / sqrtf(s * (1.f / DM) + RMS_EPS); }
            }
        }
        SEAM(P + 0);
        if (IN(P + 1)) {
            { pg8::Gemm g{hb, Wqkv_t, MTOK, DM + nkv, DM}; pg8::FixedOrder S; S.init(MTOK, DM + nkv, G, wg);
              pg8::EpiRowScale E{qkb, DM + nkv, make_rowscale(lds, S, rstdA, nullptr), DM / 256, QSCALE};
              pg8::gemm_phase<pg8::EpiRowScale, pg8::FixedOrder, PG8_ALIGN, PG8_SP2>(lds, g, S, E); }
            { pg8::Gemm g{Wqkv_t + (size_t)(DM + nkv) * DM, hb, nkv, MTOK, DM}; pg8::StaticOrder S; S.init(nkv, MTOK, G, wg);
              pg8::EpiColScale E{vTb, MTOK, rstdA};
              pg8::gemm_phase<pg8::EpiColScale, pg8::StaticOrder, PG8_ALIGN, PG8_SP2>(lds, g, S, E); }
            if (l == 1) flogit_phase(lds, hb, wf_t, rstdA, args.in[12], flog, G, wg);
        }
        SEAM(P + 1);
        if (l == 1) { if (IN(P + 2)) cumsum_phase(lds, flog, c2, G, wg); SEAM(P + 2); }
        if (IN(P + 3)) {
            const BgCvt<l ? 8 : 16> bg{CvtJob{args.in[l ? 15 : 3], nullptr, Wo_t, DM, DM, 0}, CvtJob{args.in[l ? 17 : 5], args.in[l ? 16 : 4], Wup_t, DM, FF2, 1}, CvtJob{args.in[l ? 20 : 8], nullptr, Wdown_t, FF, DM, 0},
                     l ? 0 : CVT_NITEMS(DM, DM), l ? 0 : CVT_NITEMS(DM, FF2), l ? 0 : CVT_NITEMS(FF, DM), gw, NGW};
            if constexpr (l == 0) attn_phase<false>(lds, qkb, 2 * DM, DM, 0, vTb, nullptr, ob, G, wg, bg);
            else if (wg < G - conv_wgs) attn_phase<true>(lds, qkb, DM + 1024, DM, 2, vTb, c2, ob, G - conv_wgs, wg, bg);
            else { LAS unsigned char* cscr = lds + wave * 18432; const int cw = (wg - (G - conv_wgs)) * NWAVES + wave, T = conv_wgs * NWAVES;
                   constexpr int m4 = CVT_NITEMS2(FF, DM);
                   for (int it = cw; it < conv_d3 + m4; it += T) {
                       if (it < conv_d3) { cvt_item2(jB3, it, lane, cscr); asm volatile("; job B3"); } else { cvt_item2(jB4, it - conv_d3, lane, cscr); asm volatile("; job B4"); }
                   } }
        }
        SEAM(P + 3);
        if (IN(P + 4)) {
            pg8::Gemm g{ob, Wo_t, MTOK, DM, DM}; pg8::StaticOrder S; S.init(MTOK, DM, G, wg);
            pg8::EpiResid E{hb, part, DM};
            pg8::gemm_phase<pg8::EpiResid, pg8::StaticOrder, PG8_ALIGN, PG8_SP2>(lds, g, S, E);
        }
        SEAM(P + 4);
        if (IN(P + 6)) {
            pg8::Gemm g{hb, Wup_t, MTOK, FF2, DM}; pg8::FixedOrder S; S.init(MTOK, FF2, G, wg);
            pg8::EpiGlu E{actb, make_rowscale(lds, S, nullptr, part), args.in[l ? 18 : 6], args.in[l ? 19 : 7], glast, pfirst, vfirst};
            pg8::gemm_phase<pg8::EpiGlu, pg8::FixedOrder, PG8_ALIGN, PG8_SP2>(lds, g, S, E);
        }
        SEAM(P + 6);
        if (IN(P + 7)) convfix_phase(glast, pfirst, vfirst, args.in[l ? 18 : 6], actb, G, wg);
        SEAM(P + 7);
        if (IN(P + 8)) {
            pg8::Gemm g{actb, Wdown_t, MTOK, DM, FF}; pg8::StaticOrder S; S.init(MTOK, DM, G, wg, 4);
            pg8::EpiResid E{hb, part, DM};
            pg8::gemm_phase<pg8::EpiResid, pg8::StaticOrder, PG8_ALIGN, PG8_SP2>(lds, g, S, E);
        }
        SEAM(P + 8);
    };
    layer(std::integral_constant<int, 0>{});
    layer(std::integral_constant<int, 1>{});
    if (IN(18)) {
        const float* gfin = args.in[21];
        for (int m = gw; m < MTOK; m += NGW) {
            const u32x4* xr = (const u32x4*)(hb + (size_t)m * DM) + lane; float v[8][8]; float s = 0.f;
#pragma unroll
            for (int j = 0; j < 8; ++j) { unpack8(xr[64 * j], v[j]);
#pragma unroll
                for (int i = 0; i < 8; ++i) s += v[j][i] * v[j][i]; }
            s = wave_sum(s);
            const float rs = 1.f / sqrtf(s * (1.f / DM) + RMS_EPS);
            float* orow = hres + (size_t)m * DM;
#pragma unroll
            for (int j = 0; j < 8; ++j) { const int c0 = 8 * (lane + 64 * j); const f32x4 g0 = *(const f32x4*)(gfin + c0), g1 = *(const f32x4*)(gfin + c0 + 4);
                *(f32x4*)(orow + c0) = (f32x4){v[j][0] * rs * g0[0], v[j][1] * rs * g0[1], v[j][2] * rs * g0[2], v[j][3] * rs * g0[3]};
                *(f32x4*)(orow + c0 + 4) = (f32x4){v[j][4] * rs * g1[0], v[j][5] * rs * g1[1], v[j][6] * rs * g1[2], v[j][7] * rs * g1[3]}; }
        }
    }
#undef IN
#undef SEAM
    if (MK_N_LAUNCHES == 1) {
        __syncthreads();
        if (tid == 0) MISC[16] = (xb_add(&g_ctl[XB_EXIT], 1u) == (unsigned)G - 1u) ? 1u : 0u;
        __syncthreads();
        if (MISC[16]) for (int i = tid; i < XCD_BAR_WORDS + 64; i += NWAVES * 64) g_ctl[i] = 0u;
    }
}

extern "C" void kernel_launch(void* const* d_in, const int* in_sizes, int n_in, void* d_out, int out_size, void* d_ws, size_t ws_size, hipStream_t stream) {
    static int grid = 0;
    if (grid == 0) {
        if (n_in != 22 || out_size != MTOK * DM || ws_size < WS_END) { fprintf(stderr, "kernel_launch: unexpected shapes (n_in %d out %d ws %zu need %zu)\n", n_in, out_size, ws_size, (size_t)WS_END); grid = -1; return; }
        int dev = 0, cus = 0, per_cu = 0;
        if (hipGetDevice(&dev) != hipSuccess || hipDeviceGetAttribute(&cus, hipDeviceAttributeMultiprocessorCount, dev) != hipSuccess) { grid = -1; return; }
        if (hipFuncSetAttribute((const void*)yoco_fwd, hipFuncAttributeMaxDynamicSharedMemorySize, LDS_BYTES) != hipSuccess) { fprintf(stderr, "kernel_launch: hipFuncSetAttribute failed\n"); grid = -1; return; }
        if (hipOccupancyMaxActiveBlocksPerMultiprocessor(&per_cu, (const void*)yoco_fwd, NWAVES * 64, LDS_BYTES) != hipSuccess || per_cu < 1) { fprintf(stderr, "kernel_launch: occupancy query says %d blocks per CU\n", per_cu); }
        (void)hipGetLastError();
        grid = cus;
        if (grid % 8 != 0 || grid < 64) { fprintf(stderr, "kernel_launch: %d CUs: the row-panel order needs a multiple of 8 and at least 64 workgroups\n", grid); grid = -1; return; }
    }
    if (grid < 0) return;
    (void)in_sizes;
    Args a{};
    for (int i = 0; i < 22; ++i) a.in[i] = (const float*)d_in[i];
    a.out = (float*)d_out; a.ws = (unsigned char*)d_ws;
    if (MK_N_LAUNCHES == 1) {
        a.ph_lo = 0; a.ph_hi = N_PHASES;
        hipLaunchKernelGGL(yoco_fwd, dim3(grid), dim3(NWAVES * 64), LDS_BYTES, stream, a);
    } else {
        for (int p = 0; p < N_PHASES; ++p) {
            if (p == 2) continue;
            a.ph_lo = p; a.ph_hi = p + 1;
            hipLaunchKernelGGL(yoco_fwd, dim3(grid), dim3(NWAVES * 64), LDS_BYTES, stream, a);
        }
    }
    const hipError_t le = hipPeekAtLastError();
    if (le != hipSuccess) fprintf(stderr, "kernel_launch: launch failed: %s\n", hipGetErrorName(le));
}
```

```cpp
#include <hip/hip_runtime.h>
#include <cstdio>
#include <cstdint>
#include <type_traits>

#define LAS __attribute__((address_space(3)))
typedef unsigned short bf16_t;
typedef short bf16x8 __attribute__((ext_vector_type(8)));
typedef float f32x4 __attribute__((ext_vector_type(4)));
typedef float f32x16 __attribute__((ext_vector_type(16)));
typedef unsigned u32x4 __attribute__((ext_vector_type(4)));
typedef unsigned u32x2 __attribute__((ext_vector_type(2)));

#ifndef MK_N_LAUNCHES
#define MK_N_LAUNCHES 1
#endif

constexpr int DM = 4096, NB = 8, SEQ = 2048, MTOK = NB * SEQ, HD = 128, NH = 32, FF = 11008, FF2 = 2 * FF;
constexpr float RMS_EPS = 1e-6f;
constexpr float QSCALE = 0.08838834764831845f * 1.4426950408889634f;
constexpr float LOG2E = 1.4426950408889634f;
constexpr int NWAVES = 8;
constexpr int N_PHASES = 19;

constexpr size_t MiB = 1u << 20;
constexpr size_t WS_CTL = 0, CTL_ZERO_BYTES = 64 * 1024;
constexpr size_t WS_RSTDA = 1 * MiB;
constexpr size_t WS_RSTDF = WS_RSTDA + 64 * 1024;
constexpr size_t WS_WF = 2 * MiB;
constexpr size_t WS_FLOG = 3 * MiB;
constexpr size_t WS_C2 = 5 * MiB;
constexpr size_t WS_PART = 8 * MiB;
constexpr size_t WS_W = 16 * MiB;
constexpr size_t W_QKV = 0, W_O = 96 * MiB, W_UP = 128 * MiB, W_DOWN = 300 * MiB, W_END = 386 * MiB;
constexpr size_t WS_HB = WS_W + W_END;
constexpr size_t WS_R = WS_HB + 128 * MiB;
constexpr size_t R_QK = 0, R_VT = 256 * MiB, R_O = 384 * MiB, R_END = 512 * MiB;
constexpr size_t WS_ACT = WS_R + R_END;
constexpr size_t WS_SIDE = WS_ACT + 344 * MiB;
constexpr size_t SIDE_ONE = (size_t)256 * 2 * 11008 * 4;
constexpr size_t WS_END = WS_SIDE + 66 * MiB;
constexpr int CONV_WGS = 48, CONV_D3 = 8192;
constexpr int CW_BAR = 1024;

constexpr int RING_BYTES = 131072, BGSCR_OFF = 81920  , LDSCTL_OFF = 155648, MISC_OFF = LDSCTL_OFF + 320, LDS_BYTES = 157696;

__device__ __forceinline__ unsigned cvt_pk_bf16(float lo, float hi) { unsigned r; asm volatile("v_cvt_pk_bf16_f32 %0, %1, %2" : "=v"(r) : "v"(lo), "v"(hi)); return r; }
__device__ __forceinline__ float bf2f(unsigned short b) { return __uint_as_float(((unsigned)b) << 16); }

namespace pg8 {
constexpr int BM = 256, BK = 64, HALF = 128, HTB = HALF * BK * 2, STAGE_BYTES = 8 * HTB, NXCD = 8, WGM = 8;
__host__ __device__ __forceinline__ int lds_byte(int r, int c) { const int st = (r >> 4) * 2 + (c >> 5), rr = r & 15, cc = c & 31, ob = rr * 64 + cc * 2; return st * 1024 + (ob ^ (((ob >> 9) & 1) << 5)); }
__host__ __device__ __forceinline__ void stage_rc(int b, int& R, int& C) { const int st = b / 1024, sb = b % 1024, swz = sb ^ (((sb >> 9) & 1) << 5); R = (st >> 1) * 16 + swz / 64; C = (st & 1) * 32 + (swz % 64) / 2; }
__host__ __device__ __forceinline__ int perm32(int rho) { const int n = rho >> 4, i = rho & 15; return 8 * (i >> 2) + 4 * n + (i & 3); }

struct Unit { int pm, pn; };
struct Gemm { const bf16_t* A; const bf16_t* Bt; int M, N, K; };

struct StaticOrder {
    int nM, nN, nwg, G, c, wgm;
    __host__ __device__ void init(int M, int N, int G_, int c_, int wgm_ = WGM) { nM = M / BM; nN = N / BM; nwg = nM * nN; G = G_; c = c_; wgm = wgm_; }
    __host__ __device__ bool next(int i, Unit& u) const {
        const long L = (long)i * G + c; if (L >= nwg) return false;
        int wgid = (int)L; { const int q = nwg / NXCD, r = nwg % NXCD, xcd = wgid % NXCD, off = wgid / NXCD; wgid = (xcd < r ? xcd * (q + 1) : r * (q + 1) + (xcd - r) * q) + off; }
        const int nig = wgm * nN, gid = wgid / nig, fm = gid * wgm, gsz = (nM - fm) < wgm ? (nM - fm) : wgm;
        u.pm = fm + ((wgid % nig) % gsz); u.pn = (wgid % nig) / gsz; return true;
    }
    __device__ __forceinline__ void a_ready(const Unit&) const {}
    __device__ __forceinline__ void done(const Unit&) const {}
};

struct FixedOrder {
    int nN, ppx, wpp, pm, slot;
    __host__ __device__ void init(int M, int N, int G, int c) { const int nM = M / BM; nN = N / BM; ppx = nM / NXCD; wpp = (G / NXCD) / ppx; const int x = c % NXCD, j = c / NXCD; pm = ppx * x + j % ppx; slot = j / ppx; }
    __host__ __device__ bool next(int i, Unit& u) const { if (wpp == 0 || slot >= wpp) return false; const int pn = slot + i * wpp; if (pn >= nN) return false; u.pm = pm; u.pn = pn; return true; }
    __device__ __forceinline__ void a_ready(const Unit&) const {}
    __device__ __forceinline__ void done(const Unit&) const {}
};

struct RowScale {
    const LAS float* tab;
    __device__ __forceinline__ void get8(int rbase, float (&sc)[2][4]) const {
        const unsigned a = (unsigned)(size_t)(tab + rbase);
        asm volatile("ds_read_b32 %0, %8\n\tds_read_b32 %1, %8 offset:64\n\tds_read_b32 %2, %8 offset:128\n\tds_read_b32 %3, %8 offset:192\n\t"
                     "ds_read_b32 %4, %8 offset:512\n\tds_read_b32 %5, %8 offset:576\n\tds_read_b32 %6, %8 offset:640\n\tds_read_b32 %7, %8 offset:704\n\ts_waitcnt lgkmcnt(0)"
                     : "=&v"(sc[0][0]), "=&v"(sc[0][1]), "=&v"(sc[0][2]), "=&v"(sc[0][3]), "=&v"(sc[1][0]), "=&v"(sc[1][1]), "=&v"(sc[1][2]), "=&v"(sc[1][3]) : "v"(a) : "memory");
    }
};
struct EpiRowScale {
    static constexpr bool PERM = true, AFTER_DRAIN = false;
    bf16_t* O; int ldc; RowScale rs; int qtiles; float qscale;
    __device__ __forceinline__ void operator()(const f32x4 (&acc)[2][2][4][2], const Unit& u, int wr, int wc, int fr, int fq) const {
        const int row0 = u.pm * BM + wr * 64 + fr, col0 = u.pn * BM + wc * 32 + 8 * fq;
        const float sc = (u.pn < qtiles) ? qscale : 1.f;
        float s8[2][4]; rs.get8(wr * 64 + fr, s8);
#pragma unroll
        for (int ai = 0; ai < 2; ++ai)
#pragma unroll
            for (int m = 0; m < 4; ++m) { const int row = row0 + ai * HALF + m * 16; const float s = s8[ai][m] * sc; bf16_t* rowp = O + (size_t)row * ldc + col0;
#pragma unroll
                for (int bj = 0; bj < 2; ++bj) { const f32x4 v0 = acc[ai][bj][m][0] * s, v1 = acc[ai][bj][m][1] * s;
                    u32x4 w; w.x = cvt_pk_bf16(v0[0], v0[1]); w.y = cvt_pk_bf16(v0[2], v0[3]); w.z = cvt_pk_bf16(v1[0], v1[1]); w.w = cvt_pk_bf16(v1[2], v1[3]);
                    *(u32x4*)(rowp + bj * HALF) = w; } }
    }
};
struct EpiColScale {
    static constexpr bool PERM = true, AFTER_DRAIN = false;
    bf16_t* O; int ldc; const float* cs;
    __device__ __forceinline__ void operator()(const f32x4 (&acc)[2][2][4][2], const Unit& u, int wr, int wc, int fr, int fq) const {
        const int row0 = u.pm * BM + wr * 64 + fr, col0 = u.pn * BM + wc * 32 + 8 * fq;
        f32x4 s[2][2];
#pragma unroll
        for (int bj = 0; bj < 2; ++bj) { s[bj][0] = *(const f32x4*)(cs + col0 + bj * HALF); s[bj][1] = *(const f32x4*)(cs + col0 + bj * HALF + 4); }
#pragma unroll
        for (int ai = 0; ai < 2; ++ai)
#pragma unroll
            for (int m = 0; m < 4; ++m) { const int row = row0 + ai * HALF + m * 16; bf16_t* rowp = O + (size_t)row * ldc + col0;
#pragma unroll
                for (int bj = 0; bj < 2; ++bj) { const f32x4 v0 = acc[ai][bj][m][0] * s[bj][0], v1 = acc[ai][bj][m][1] * s[bj][1];
                    u32x4 w; w.x = cvt_pk_bf16(v0[0], v0[1]); w.y = cvt_pk_bf16(v0[2], v0[3]); w.z = cvt_pk_bf16(v1[0], v1[1]); w.w = cvt_pk_bf16(v1[2], v1[3]);
                    *(u32x4*)(rowp + bj * HALF) = w; } }
    }
};
__device__ __forceinline__ float dpp_ror1(float v) { return __builtin_bit_cast(float, __builtin_amdgcn_update_dpp(__builtin_bit_cast(int, v), __builtin_bit_cast(int, v), 0x121, 0xf, 0xf, false)); }
__device__ __forceinline__ float dpp_ror2(float v) { return __builtin_bit_cast(float, __builtin_amdgcn_update_dpp(__builtin_bit_cast(int, v), __builtin_bit_cast(int, v), 0x122, 0xf, 0xf, false)); }
struct EpiGlu {
    static constexpr bool PERM = true, AFTER_DRAIN = false;
    bf16_t* act; RowScale rs; const float* wconv; const float* bconv; float* glast; float* pfirst; float* vfirst;
    __device__ __forceinline__ void operator()(const f32x4 (&acc)[2][2][4][2], const Unit& u, int wr, int wc, int fr, int fq) const {
        typedef float f32x2 __attribute__((ext_vector_type(2)));
        constexpr int FFc = 11008;
        const int f0 = u.pn * HALF + wc * 32 + 8 * fq;
        f32x2 w0[4], w1[4], w2[4], bb[4];
#pragma unroll
        for (int q = 0; q < 2; ++q) { const f32x4 a = *(const f32x4*)(wconv + f0 + 4 * q), b = *(const f32x4*)(wconv + FFc + f0 + 4 * q), c = *(const f32x4*)(wconv + 2 * FFc + f0 + 4 * q), d = *(const f32x4*)(bconv + f0 + 4 * q);
            w0[2 * q] = (f32x2){a[0], a[1]}; w0[2 * q + 1] = (f32x2){a[2], a[3]}; w1[2 * q] = (f32x2){b[0], b[1]}; w1[2 * q + 1] = (f32x2){b[2], b[3]};
            w2[2 * q] = (f32x2){c[0], c[1]}; w2[2 * q + 1] = (f32x2){c[2], c[3]}; bb[2 * q] = (f32x2){d[0], d[1]}; bb[2 * q + 1] = (f32x2){d[2], d[3]}; }
        const bool l15 = fr == 15, l14 = fr >= 14;
        float s8[2][4]; rs.get8(wr * 64 + fr, s8);
#pragma unroll
        for (int ai = 0; ai < 2; ++ai) {
            const int blk = u.pm * 4 + ai * 2 + wr;
            f32x2 gp[4];
#pragma unroll
            for (int q = 0; q < 4; ++q) gp[q] = (f32x2){0.f, 0.f};
#pragma unroll
            for (int m = 0; m < 4; ++m) {
                const int row = u.pm * BM + ai * HALF + wr * 64 + m * 16 + fr; const float s = s8[ai][m];
                f32x2 g[4], v[4], x1[4], x2[4], p1[4], p2[4], c[4], y[4];
#pragma unroll
                for (int q = 0; q < 4; ++q) { g[q] = (f32x2){acc[ai][0][m][q >> 1][2 * (q & 1)], acc[ai][0][m][q >> 1][2 * (q & 1) + 1]} * s; v[q] = (f32x2){acc[ai][1][m][q >> 1][2 * (q & 1)], acc[ai][1][m][q >> 1][2 * (q & 1) + 1]} * s; }
#pragma unroll
                for (int q = 0; q < 4; ++q) { x1[q].x = l15 ? gp[q].x : g[q].x; x1[q].y = l15 ? gp[q].y : g[q].y; x2[q].x = l14 ? gp[q].x : g[q].x; x2[q].y = l14 ? gp[q].y : g[q].y; }
#pragma unroll
                for (int q = 0; q < 4; ++q) { p1[q].x = dpp_ror1(x1[q].x); p1[q].y = dpp_ror1(x1[q].y); p2[q].x = dpp_ror2(x2[q].x); p2[q].y = dpp_ror2(x2[q].y); }
#pragma unroll
                for (int q = 0; q < 4; ++q) { c[q] = bb[q] + w0[q] * p2[q] + w1[q] * p1[q] + w2[q] * g[q];
                    const f32x2 t = c[q] * (-1.4426950408889634f); f32x2 e; e.x = __builtin_amdgcn_exp2f(t.x); e.y = __builtin_amdgcn_exp2f(t.y);
                    const f32x2 d = e + 1.f; f32x2 r; r.x = __builtin_amdgcn_rcpf(d.x); r.y = __builtin_amdgcn_rcpf(d.y);
                    y[q] = c[q] * r * v[q]; }
                u32x4 w; w.x = cvt_pk_bf16(y[0].x, y[0].y); w.y = cvt_pk_bf16(y[1].x, y[1].y); w.z = cvt_pk_bf16(y[2].x, y[2].y); w.w = cvt_pk_bf16(y[3].x, y[3].y);
                *(u32x4*)(act + (size_t)row * FFc + f0) = w;
                if (m == 0 && fr < 2) { float* pp = pfirst + ((size_t)blk * 2 + fr) * FFc + f0; float* vp = vfirst + ((size_t)blk * 2 + fr) * FFc + f0;
                    *(f32x4*)pp = (f32x4){c[0].x, c[0].y, c[1].x, c[1].y}; *(f32x4*)(pp + 4) = (f32x4){c[2].x, c[2].y, c[3].x, c[3].y};
                    *(f32x4*)vp = (f32x4){v[0].x, v[0].y, v[1].x, v[1].y}; *(f32x4*)(vp + 4) = (f32x4){v[2].x, v[2].y, v[3].x, v[3].y}; }
                if (m == 3 && fr >= 14) { float* gl = glast + ((size_t)blk * 2 + (fr - 14)) * FFc + f0;
                    *(f32x4*)gl = (f32x4){g[0].x, g[0].y, g[1].x, g[1].y}; *(f32x4*)(gl + 4) = (f32x4){g[2].x, g[2].y, g[3].x, g[3].y}; }
#pragma unroll
                for (int q = 0; q < 4; ++q) gp[q] = g[q];
            }
        }
    }
};
struct EpiResid {
    static constexpr bool PERM = true, AFTER_DRAIN = false;
    bf16_t* hb; float* part; int ldc;
    __device__ __forceinline__ void operator()(const f32x4 (&acc)[2][2][4][2], const Unit& u, int wr, int wc, int fr, int fq) const {
        const int row0 = u.pm * BM + wr * 64 + fr, col0 = u.pn * BM + wc * 32 + 8 * fq;
        u32x4 bs[2][4][2];
#pragma unroll
        for (int ai = 0; ai < 2; ++ai)
#pragma unroll
            for (int m = 0; m < 4; ++m)
#pragma unroll
                for (int bj = 0; bj < 2; ++bj) bs[ai][m][bj] = *(const u32x4*)(hb + (size_t)(row0 + ai * HALF + m * 16) * ldc + col0 + bj * HALF);
#pragma unroll
        for (int ai = 0; ai < 2; ++ai)
#pragma unroll
            for (int m = 0; m < 4; ++m) { const int row = row0 + ai * HALF + m * 16; const size_t off = (size_t)row * ldc + col0; float ss = 0.f;
#pragma unroll
                for (int bj = 0; bj < 2; ++bj) { const u32x4 b = bs[ai][m][bj];
                    f32x4 v0, v1;
                    v0[0] = acc[ai][bj][m][0][0] + __uint_as_float(b.x << 16); v0[1] = acc[ai][bj][m][0][1] + __uint_as_float(b.x & 0xffff0000u);
                    v0[2] = acc[ai][bj][m][0][2] + __uint_as_float(b.y << 16); v0[3] = acc[ai][bj][m][0][3] + __uint_as_float(b.y & 0xffff0000u);
                    v1[0] = acc[ai][bj][m][1][0] + __uint_as_float(b.z << 16); v1[1] = acc[ai][bj][m][1][1] + __uint_as_float(b.z & 0xffff0000u);
                    v1[2] = acc[ai][bj][m][1][2] + __uint_as_float(b.w << 16); v1[3] = acc[ai][bj][m][1][3] + __uint_as_float(b.w & 0xffff0000u);
                    u32x4 w; w.x = cvt_pk_bf16(v0[0], v0[1]); w.y = cvt_pk_bf16(v0[2], v0[3]); w.z = cvt_pk_bf16(v1[0], v1[1]); w.w = cvt_pk_bf16(v1[2], v1[3]);
                    *(u32x4*)(hb + off + bj * HALF) = w;
                    ss += (v0[0] * v0[0] + v0[1] * v0[1]) + (v0[2] * v0[2] + v0[3] * v0[3]) + (v1[0] * v1[0] + v1[1] * v1[1]) + (v1[2] * v1[2] + v1[3] * v1[3]); }
                ss += __shfl_xor(ss, 16); ss += __shfl_xor(ss, 32);
                if (fq == 0) part[(size_t)row * 64 + u.pn * 4 + wc] = ss; }
    }
};

template <class Epi, class Sched, bool ALIGN_EPI = false, bool SP2 = false>
__device__ __forceinline__ void gemm_phase(LAS unsigned char* lds, const Gemm g, const Sched& S, const Epi& E) {
    const int tid = threadIdx.x, wid = __builtin_amdgcn_readfirstlane(tid >> 6), lane = tid & 63, wr = wid >> 2, wc = wid & 3, fr = lane & 15, fq = lane >> 4;
    const int K = g.K, nt = K / BK;
    unsigned voffA[2], voffB[2];
#pragma unroll
    for (int i = 0; i < 2; ++i) { int R, C; stage_rc(tid * 16 + i * 8192, R, C); const int Rb = Epi::PERM ? ((R & ~31) + perm32(R & 31)) : R;
        voffA[i] = (unsigned)(R * K + C) * 2u; voffB[i] = (unsigned)(Rb * K + C) * 2u; }
    const unsigned kstep = (unsigned)(BK * 2);
    const unsigned hstep = (unsigned)HALF * (unsigned)K * 2u;
    const unsigned tstep = 2u * hstep;
    const __amdgpu_buffer_rsrc_t rsrcA = __builtin_amdgcn_make_buffer_rsrc((void*)g.A, 0, 0x7fffffff, 0x00020000), rsrcB = __builtin_amdgcn_make_buffer_rsrc((void*)g.Bt, 0, 0x7fffffff, 0x00020000);
    const unsigned ldsw = (unsigned)wid * 1024u;
    const int aoff = lds_byte(wr * 64 + fr, fq * 8), boff = lds_byte(wc * 32 + fr, fq * 8);
#define PG8_SA(b, h) (((b) * 2 + (h)) * HTB)
#define PG8_SB(b, h) ((4 + (b) * 2 + (h)) * HTB)
#define PG8_STAGE(bufoff, gbase, voff) do { _Pragma("unroll") for (int _i = 0; _i < 2; ++_i) \
        __builtin_amdgcn_raw_ptr_buffer_load_lds(PG8_RSRC_##voff, (LAS void*)(lds + (bufoff) + ldsw + _i * 8192), 16, (voff)[_i], (int)(gbase), 0, 0); } while (0)
#define PG8_RSRC_voffA rsrcA
#define PG8_RSRC_voffB rsrcB
#define PG8_LDA(dst, b, h) do { _Pragma("unroll") for (int m = 0; m < 4; ++m) _Pragma("unroll") for (int k = 0; k < 2; ++k) dst[m][k] = *(const LAS bf16x8*)(lds + PG8_SA(b, h) + aoff + m * 2048 + k * 1024); } while (0)
#define PG8_LDB(dst, b, h) do { _Pragma("unroll") for (int n = 0; n < 2; ++n) _Pragma("unroll") for (int k = 0; k < 2; ++k) dst[n][k] = *(const LAS bf16x8*)(lds + PG8_SB(b, h) + boff + n * 2048 + k * 1024); } while (0)
#define PG8_MMA(ai, bj, At, Bt) do { __builtin_amdgcn_s_setprio(1); _Pragma("unroll") for (int m = 0; m < 4; ++m) _Pragma("unroll") for (int n = 0; n < 2; ++n) _Pragma("unroll") for (int k = 0; k < 2; ++k) \
        acc[ai][bj][m][n] = __builtin_amdgcn_mfma_f32_16x16x32_bf16(Bt[n][k], At[m][k], acc[ai][bj][m][n], 0, 0, 0); __builtin_amdgcn_s_setprio(0); } while (0)
#define PG8_WAIT_V(n) asm volatile("s_waitcnt vmcnt(" #n ")" ::: "memory")
#define PG8_WAIT_L(n) asm volatile("s_waitcnt lgkmcnt(" #n ")" ::: "memory")
#define PG8_BAR __builtin_amdgcn_s_barrier()
#define PG8_SCHED __builtin_amdgcn_sched_barrier(0)
    Unit cur, nxt; int ui = 0;
    if (!S.next(0, cur)) return;
    f32x4 acc[2][2][4][2];
#pragma unroll
    for (int a = 0; a < 2; ++a)
#pragma unroll
        for (int b = 0; b < 2; ++b)
#pragma unroll
            for (int m = 0; m < 4; ++m)
#pragma unroll
                for (int n = 0; n < 2; ++n) acc[a][b][m][n] = (f32x4){0.f, 0.f, 0.f, 0.f};
    bf16x8 At[4][2], B0[2][2], B1[2][2];
    unsigned cA = (unsigned)cur.pm * tstep, cB = (unsigned)cur.pn * tstep;
    S.a_ready(cur);
    if constexpr (SP2) {
        PG8_STAGE(PG8_SB(0, 0), cB, voffB); PG8_STAGE(PG8_SB(0, 1), cB + hstep, voffB); PG8_STAGE(PG8_SA(0, 0), cA, voffA); PG8_STAGE(PG8_SA(0, 1), cA + hstep, voffA);
        if (wr == 1) PG8_BAR;
        PG8_WAIT_V(2); PG8_BAR;
        PG8_STAGE(PG8_SB(1, 0), cB + kstep, voffB); PG8_STAGE(PG8_SA(1, 0), cA + kstep, voffA); PG8_STAGE(PG8_SB(1, 1), cB + hstep + kstep, voffB);
        PG8_WAIT_V(6); PG8_BAR;
    } else {
        PG8_STAGE(PG8_SB(0, 0), cB, voffB); PG8_STAGE(PG8_SA(0, 0), cA, voffA); PG8_STAGE(PG8_SB(0, 1), cB + hstep, voffB); PG8_STAGE(PG8_SA(0, 1), cA + hstep, voffA);
        if (wr == 1) PG8_BAR;
        PG8_WAIT_V(4); PG8_BAR;
        PG8_STAGE(PG8_SB(1, 0), cB + kstep, voffB); PG8_STAGE(PG8_SA(1, 0), cA + kstep, voffA); PG8_STAGE(PG8_SB(1, 1), cB + hstep + kstep, voffB);
        PG8_WAIT_V(6); PG8_BAR;
    }
    for (;;) {
        const bool has_next = S.next(ui + 1, nxt);
        const unsigned nA = has_next ? (unsigned)nxt.pm * tstep : cA, nB = has_next ? (unsigned)nxt.pn * tstep : cB;
        for (int t = 0; t < nt; t += 2) {
            const bool last = (t == nt - 2);
            const unsigned a1 = cA + (unsigned)(t + 1) * kstep;
            const unsigned a2 = last ? nA : cA + (unsigned)(t + 2) * kstep, b2 = last ? nB : cB + (unsigned)(t + 2) * kstep;
            const unsigned a3 = a2 + kstep, b3 = b2 + kstep;
            if (last && has_next) S.a_ready(nxt);
            if constexpr (SP2) {
            PG8_LDB(B0, 0, 0); PG8_LDB(B1, 0, 1); PG8_SCHED; PG8_LDA(At, 0, 0); PG8_STAGE(PG8_SA(1, 1), a1 + hstep, voffA);
            PG8_WAIT_V(8); PG8_WAIT_L(0); PG8_BAR; PG8_MMA(0, 0, At, B0); PG8_MMA(0, 1, At, B1); PG8_BAR; PG8_SCHED;
            PG8_LDA(At, 0, 1); PG8_STAGE(PG8_SB(0, 0), b2, voffB); PG8_STAGE(PG8_SB(0, 1), b2 + hstep, voffB); PG8_STAGE(PG8_SA(0, 0), a2, voffA);
            PG8_WAIT_V(8); PG8_WAIT_L(0); PG8_BAR; PG8_MMA(1, 0, At, B0); PG8_MMA(1, 1, At, B1); PG8_BAR; PG8_SCHED;
            PG8_LDB(B0, 1, 0); PG8_LDB(B1, 1, 1); PG8_SCHED; PG8_LDA(At, 1, 0); PG8_STAGE(PG8_SA(0, 1), a2 + hstep, voffA);
            PG8_WAIT_V(8); PG8_WAIT_L(0); PG8_BAR; PG8_MMA(0, 0, At, B0); PG8_MMA(0, 1, At, B1); PG8_BAR; PG8_SCHED;
            PG8_LDA(At, 1, 1); PG8_STAGE(PG8_SB(1, 0), b3, voffB); PG8_STAGE(PG8_SB(1, 1), b3 + hstep, voffB); PG8_STAGE(PG8_SA(1, 0), a3, voffA);
            PG8_WAIT_V(8); PG8_WAIT_L(0); PG8_BAR; PG8_MMA(1, 0, At, B0); PG8_MMA(1, 1, At, B1); PG8_BAR; PG8_SCHED;
            } else {
            PG8_LDB(B0, 0, 0); PG8_SCHED; PG8_LDA(At, 0, 0); PG8_STAGE(PG8_SA(1, 1), a1 + hstep, voffA);
            PG8_WAIT_L(8); PG8_BAR; PG8_WAIT_L(0); PG8_MMA(0, 0, At, B0); PG8_BAR; PG8_SCHED;
            PG8_LDB(B1, 0, 1); PG8_STAGE(PG8_SB(0, 0), b2, voffB);
            PG8_BAR; PG8_WAIT_L(0); PG8_MMA(0, 1, At, B1); PG8_BAR;
            PG8_LDA(At, 0, 1); PG8_STAGE(PG8_SA(0, 0), a2, voffA);
            PG8_BAR; PG8_WAIT_L(0); PG8_MMA(1, 0, At, B0); PG8_BAR; PG8_SCHED;
            PG8_STAGE(PG8_SB(0, 1), b2 + hstep, voffB);
            PG8_WAIT_V(6); PG8_BAR; PG8_MMA(1, 1, At, B1); PG8_BAR;
            PG8_LDB(B0, 1, 0); PG8_SCHED; PG8_LDA(At, 1, 0); PG8_STAGE(PG8_SA(0, 1), a2 + hstep, voffA);
            PG8_WAIT_L(8); PG8_BAR; PG8_WAIT_L(0); PG8_MMA(0, 0, At, B0); PG8_BAR; PG8_SCHED;
            PG8_LDB(B1, 1, 1); PG8_STAGE(PG8_SB(1, 0), b3, voffB);
            PG8_BAR; PG8_WAIT_L(0); PG8_MMA(0, 1, At, B1); PG8_BAR;
            PG8_LDA(At, 1, 1); PG8_STAGE(PG8_SA(1, 0), a3, voffA);
            PG8_BAR; PG8_WAIT_L(0); PG8_MMA(1, 0, At, B0); PG8_BAR; PG8_SCHED;
            PG8_STAGE(PG8_SB(1, 1), b3 + hstep, voffB);
            PG8_WAIT_V(6); PG8_BAR; PG8_MMA(1, 1, At, B1); PG8_BAR;
            }
        }
        if constexpr (ALIGN_EPI) { if (wr == 0) PG8_BAR; }
        if constexpr (!Epi::AFTER_DRAIN) { E(acc, cur, wr, wc, fr, fq); S.done(cur); }
        if (!has_next) break;
#pragma unroll
        for (int a = 0; a < 2; ++a)
#pragma unroll
            for (int b = 0; b < 2; ++b)
#pragma unroll
                for (int m = 0; m < 4; ++m)
#pragma unroll
                    for (int n = 0; n < 2; ++n) acc[a][b][m][n] = (f32x4){0.f, 0.f, 0.f, 0.f};
        cur = nxt; cA = nA; cB = nB; ++ui;
        if constexpr (ALIGN_EPI) { if (wr == 1) PG8_BAR; }
    }
    PG8_WAIT_V(0);
    if constexpr (!ALIGN_EPI) { if (wr == 0) PG8_BAR; }
    PG8_BAR;
#undef PG8_SA
#undef PG8_SB
#undef PG8_STAGE
#undef PG8_RSRC_voffA
#undef PG8_RSRC_voffB
#undef PG8_LDA
#undef PG8_LDB
#undef PG8_MMA
#undef PG8_WAIT_V
#undef PG8_WAIT_L
#undef PG8_BAR
#undef PG8_SCHED
}
}
#define PG8_SP2 true
#define PG8_ALIGN true
constexpr int RSTAB_OFF = LDSCTL_OFF + 1024;
__device__ __forceinline__ pg8::RowScale make_rowscale(LAS unsigned char* lds, const pg8::FixedOrder& S, const float* rstd, const float* part) {
    LAS float* tab = (LAS float*)(lds + RSTAB_OFF);
    if (threadIdx.x < 256) { const int row = S.pm * 256 + threadIdx.x; float v;
        if (rstd) v = rstd[row];
        else { const f32x4* pp = (const f32x4*)(part + (size_t)row * 64); float s = 0.f;
#pragma unroll
            for (int j = 0; j < 16; ++j) { const f32x4 q = pp[j]; s += (q[0] + q[1]) + (q[2] + q[3]); }
            v = 1.f / sqrtf(s * (1.f / 4096.f) + 1e-6f); }
        tab[threadIdx.x] = v; }
    __syncthreads();
    return pg8::RowScale{tab};
}

#define XB_TMO      128
#define XB_XCNT(j)  (256  + 64 * (j))
#define XB_XSUB(j)  (1280 + 64 * (j))
#define XB_XGEN(j)  (2304 + 64 * (j))
#define XB_TOP      3328
#define XB_TOPGEN   3392
#define XCD_BAR_WORDS 3456
#define XB_SPIN_CAP (1u << 18)
__device__ __forceinline__ unsigned xb_ld(unsigned* p)              { return __hip_atomic_load(p, __ATOMIC_RELAXED, __HIP_MEMORY_SCOPE_AGENT); }
__device__ __forceinline__ unsigned xb_add(unsigned* p, unsigned v) { return __hip_atomic_fetch_add(p, v, __ATOMIC_RELAXED, __HIP_MEMORY_SCOPE_AGENT); }
__device__ __forceinline__ unsigned xb_xcc_id() { return (unsigned)__builtin_amdgcn_s_getreg((3 << 11) | 20) & 0xFu; }
#define XB_SPIN(cond, bar) do { unsigned _sp = 0; while (cond) { __builtin_amdgcn_s_sleep(1); \
    if ((++_sp & 255u) == 0u) { if (xb_ld(&(bar)[XB_TMO])) break; if (_sp > XB_SPIN_CAP) { atomicAdd(&(bar)[XB_TMO], 1u); break; } } } } while (0)
__device__ unsigned g_ctl[XCD_BAR_WORDS + 64];
#define XB_EXIT (XCD_BAR_WORDS + 32)
struct XcdBarrier { unsigned* bar; unsigned x; volatile LAS unsigned* st; };
__device__ __forceinline__ XcdBarrier xcd_barrier_post(unsigned* bar, volatile LAS unsigned* st) {
    XcdBarrier b; b.bar = bar; b.x = xb_xcc_id(); b.st = st;
    if (threadIdx.x == 0) (void)xb_add(&bar[XB_XCNT(b.x)], 1u);
    return b;
}
__device__ __forceinline__ void xcd_barrier_complete(unsigned* bar, unsigned x, unsigned& nloc, unsigned& nx) {
    const unsigned G = gridDim.x * gridDim.y * gridDim.z;
    unsigned sum, cnt, mine, sp = 0u;
    for (;;) {
        sum = 0u; cnt = 0u; mine = 0u;
#pragma unroll
        for (unsigned j = 0; j < 16; ++j) { const unsigned c = xb_ld(&bar[XB_XCNT(j)]); sum += c; cnt += (c > 0u) ? 1u : 0u; mine = (j == x) ? c : mine; }
        if (sum == G) break;
        __builtin_amdgcn_s_sleep(1);
        if ((++sp & 255u) == 0u) { if (xb_ld(&bar[XB_TMO])) break; if (sp > XB_SPIN_CAP) { atomicAdd(&bar[XB_TMO], 1u); break; } }
    }
    nloc = mine > 0u ? mine : 1u; nx = cnt > 0u ? cnt : 1u;
}
__device__ __forceinline__ void xcd_barrier(const XcdBarrier& b) {
    asm volatile("s_waitcnt vmcnt(0)" ::: "memory");
    __syncthreads();
    if (threadIdx.x == 0) {
        unsigned* bar = b.bar;
        __builtin_amdgcn_s_waitcnt(0);
        unsigned nloc = b.st[0], nx = b.st[1];
        if (nloc == 0u) { xcd_barrier_complete(bar, b.x, nloc, nx); b.st[0] = nloc; b.st[1] = nx; }
        const unsigned old = xb_add(&bar[XB_XSUB(b.x)], 1u);
        const unsigned gen = old / nloc;
        if (old + 1u == (gen + 1u) * nloc) {
            __builtin_amdgcn_fence(__ATOMIC_RELEASE, "agent");
            asm volatile("s_waitcnt vmcnt(0)" ::: "memory");
            const unsigned og = xb_add(&bar[XB_TOP], 1u);
            const unsigned tg = og / nx;
            if (og + 1u == (tg + 1u) * nx) xb_add(&bar[XB_TOPGEN], 1u);
            else XB_SPIN(xb_ld(&bar[XB_TOPGEN]) == tg, bar);
            __builtin_amdgcn_fence(__ATOMIC_ACQUIRE, "agent");
            xb_add(&bar[XB_XGEN(b.x)], 1u);
            asm volatile("s_waitcnt vmcnt(0)" ::: "memory");
        } else {
            XB_SPIN(xb_ld(&bar[XB_XGEN(b.x)]) == gen, bar);
            __builtin_amdgcn_fence(__ATOMIC_ACQUIRE, "agent");
            asm volatile("s_waitcnt vmcnt(0)" ::: "memory");
        }
    }
    __syncthreads();
}

__device__ __forceinline__ float wave_sum(float v) {
#pragma unroll
    for (int o = 1; o < 64; o <<= 1) v += __shfl_xor(v, o);
    return v;
}
__device__ __forceinline__ float rdlane(float v, int l) { return __builtin_bit_cast(float, __builtin_amdgcn_readlane(__builtin_bit_cast(int, v), l)); }

struct CvtJob { const float* W; const float* g; bf16_t* out; int K, N; int glu; };
__device__ __forceinline__ void cvt_load(const CvtJob& jb, int item, int lane, float (&v)[64], float& gv) {
    const int nblk = jb.N >> 6; const int kb = item / nblk, nb = item - kb * nblk; const int k0 = kb * 64, n0 = nb * 64;
    gv = jb.g ? jb.g[k0 + lane] : 1.f;
    const unsigned long long src = (unsigned long long)(jb.W + (size_t)k0 * jb.N + n0);
#pragma unroll
    for (int kk = 0; kk < 64; ++kk) { const unsigned long long rp = src + (unsigned long long)kk * (unsigned long long)jb.N * 4ull;
        const unsigned lo = (unsigned)__builtin_amdgcn_readfirstlane((int)(unsigned)rp), hi = (unsigned)__builtin_amdgcn_readfirstlane((int)(unsigned)(rp >> 32));
        v[kk] = ((const __attribute__((address_space(1))) float*)(((unsigned long long)hi << 32) | lo))[(unsigned)lane]; }
}
__device__ __forceinline__ void cvt_store(const CvtJob& jb, int item, int lane, const float (&v)[64], float gv, LAS unsigned char* scr) {
    const int nblk = jb.N >> 6; const int kb = item / nblk, nb = item - kb * nblk; const int k0 = kb * 64, n0 = nb * 64;
    int nrow0 = n0;
    if (jb.glu) { const int isv = n0 >= FF ? 1 : 0, f = n0 - isv * FF; nrow0 = 256 * (f >> 7) + 128 * isv + (f & 127); }
    if (jb.g) {
#pragma unroll
    for (int c = 0; c < 8; ++c) { u32x4 o;
        o.x = cvt_pk_bf16(v[8 * c + 0] * rdlane(gv, 8 * c + 0), v[8 * c + 1] * rdlane(gv, 8 * c + 1));
        o.y = cvt_pk_bf16(v[8 * c + 2] * rdlane(gv, 8 * c + 2), v[8 * c + 3] * rdlane(gv, 8 * c + 3));
        o.z = cvt_pk_bf16(v[8 * c + 4] * rdlane(gv, 8 * c + 4), v[8 * c + 5] * rdlane(gv, 8 * c + 5));
        o.w = cvt_pk_bf16(v[8 * c + 6] * rdlane(gv, 8 * c + 6), v[8 * c + 7] * rdlane(gv, 8 * c + 7));
        *(LAS u32x4*)(scr + lane * 144 + 16 * c) = o; }
    } else {
#pragma unroll
    for (int c = 0; c < 8; ++c) { u32x4 o;
        o.x = cvt_pk_bf16(v[8 * c + 0], v[8 * c + 1]); o.y = cvt_pk_bf16(v[8 * c + 2], v[8 * c + 3]); o.z = cvt_pk_bf16(v[8 * c + 4], v[8 * c + 5]); o.w = cvt_pk_bf16(v[8 * c + 6], v[8 * c + 7]);
        *(LAS u32x4*)(scr + lane * 144 + 16 * c) = o; }
    }
    const int r = lane >> 3, cc = lane & 7;
    bf16_t* dst = jb.out + (size_t)(nrow0 + r) * jb.K + k0 + 8 * cc;
#pragma unroll
    for (int i = 0; i < 8; ++i) { const u32x4 o = *(const LAS u32x4*)(scr + (8 * i + r) * 144 + 16 * cc); *(u32x4*)(dst + (size_t)(8 * i) * jb.K) = o; }
}
#define CVT_PIPE1(JB, first, end, stride, SCR) do { int r_ = (first); const int e_ = (end), t_ = (stride); if (r_ < e_) { float va_[64], vb_[64], ga_, gb_; cvt_load(JB, r_, lane, va_, ga_); \
        for (;;) { int nx_ = r_ + t_; cvt_load(JB, nx_ < e_ ? nx_ : r_, lane, vb_, gb_); cvt_store(JB, r_, lane, va_, ga_, SCR); r_ = nx_; if (r_ >= e_) break; \
                   nx_ = r_ + t_; cvt_load(JB, nx_ < e_ ? nx_ : r_, lane, va_, ga_); cvt_store(JB, r_, lane, vb_, gb_, SCR); r_ = nx_; if (r_ >= e_) break; } } } while (0)
#define CVT_WINDOW(JB, B, n, lo, hi, w, T, SCR) do { int g0_ = (lo) + (w); if (g0_ < (B)) g0_ += (((B) - g0_ + (T) - 1) / (T)) * (T); const int eg_ = (hi) < (B) + (n) ? (hi) : (B) + (n); \
        CVT_PIPE1(JB, g0_ - (B), eg_ - (B), T, SCR); } while (0)
typedef float f32x2 __attribute__((ext_vector_type(2)));
__device__ __forceinline__ void cvt_item2(const CvtJob& jb, int item, int lane, LAS unsigned char* scr) {
    const int nblk = jb.N >> 7; const int kb = item / nblk, nb = item - kb * nblk; const int k0 = kb * 64, n0 = nb * 128;
    const float gv = jb.g ? jb.g[k0 + lane] : 1.f;
    const unsigned long long src = (unsigned long long)(jb.W + (size_t)k0 * jb.N + n0);
    f32x2 v[64];
#pragma unroll
    for (int kk = 0; kk < 64; ++kk) { const unsigned long long rp = src + (unsigned long long)kk * (unsigned long long)jb.N * 4ull;
        const unsigned lo = (unsigned)__builtin_amdgcn_readfirstlane((int)(unsigned)rp), hi = (unsigned)__builtin_amdgcn_readfirstlane((int)(unsigned)(rp >> 32));
        v[kk] = ((const __attribute__((address_space(1))) f32x2*)(((unsigned long long)hi << 32) | lo))[(unsigned)lane]; }
    int nrow0 = n0;
    if (jb.glu) { const int isv = n0 >= FF ? 1 : 0, f = n0 - isv * FF; nrow0 = 256 * (f >> 7) + 128 * isv + (f & 127); }
    if (jb.g) {
#pragma unroll
        for (int e = 0; e < 2; ++e)
#pragma unroll
            for (int c = 0; c < 8; ++c) { u32x4 o;
                o.x = cvt_pk_bf16(v[8 * c + 0][e] * rdlane(gv, 8 * c + 0), v[8 * c + 1][e] * rdlane(gv, 8 * c + 1)); o.y = cvt_pk_bf16(v[8 * c + 2][e] * rdlane(gv, 8 * c + 2), v[8 * c + 3][e] * rdlane(gv, 8 * c + 3));
                o.z = cvt_pk_bf16(v[8 * c + 4][e] * rdlane(gv, 8 * c + 4), v[8 * c + 5][e] * rdlane(gv, 8 * c + 5)); o.w = cvt_pk_bf16(v[8 * c + 6][e] * rdlane(gv, 8 * c + 6), v[8 * c + 7][e] * rdlane(gv, 8 * c + 7));
                *(LAS u32x4*)(scr + (2 * lane + e) * 144 + 16 * c) = o; }
    } else {
#pragma unroll
        for (int e = 0; e < 2; ++e)
#pragma unroll
            for (int c = 0; c < 8; ++c) { u32x4 o;
                o.x = cvt_pk_bf16(v[8 * c + 0][e], v[8 * c + 1][e]); o.y = cvt_pk_bf16(v[8 * c + 2][e], v[8 * c + 3][e]); o.z = cvt_pk_bf16(v[8 * c + 4][e], v[8 * c + 5][e]); o.w = cvt_pk_bf16(v[8 * c + 6][e], v[8 * c + 7][e]);
                *(LAS u32x4*)(scr + (2 * lane + e) * 144 + 16 * c) = o; }
    }
    const int r = lane >> 3, cc = lane & 7;
    bf16_t* dst = jb.out + (size_t)(nrow0 + r) * jb.K + k0 + 8 * cc;
#pragma unroll
    for (int i = 0; i < 16; ++i) { const u32x4 o = *(const LAS u32x4*)(scr + (8 * i + r) * 144 + 16 * cc); __builtin_nontemporal_store(o, (u32x4*)(dst + (size_t)(8 * i) * jb.K)); }
}
#define CVT_NITEMS(K, N) (((K) >> 6) * ((N) >> 6))
#define CVT_NITEMS2(K, N) (((K) >> 6) * ((N) >> 7))

template <int R>
struct BgCvt {
    CvtJob j0, j1, j2; int n0, n1, n2;
    int first, stride;
    __device__ __forceinline__ bool active(int item) const { return item < n0 + n1 + n2; }
    __device__ __forceinline__ static void loc1(const CvtJob& jb, int r, int step, const float*& src, const float*& gp, bf16_t*& dst, int& N, int& K) {
        N = jb.N; K = jb.K; const int nblk = N >> 6, kb = r / nblk, nb = r - kb * nblk, k0 = kb * 64 + R * step, n0c = nb * 64;
        int nrow0 = n0c; if (jb.glu) { const int isv = n0c >= FF ? 1 : 0, f = n0c - isv * FF; nrow0 = 256 * (f >> 7) + 128 * isv + (f & 127); }
        src = jb.W + (size_t)k0 * N + n0c; gp = jb.g ? jb.g + k0 : nullptr; dst = jb.out + (size_t)nrow0 * K + k0;
    }
    __device__ __forceinline__ void locate(int item, int step, const float*& src, const float*& gp, bf16_t*& dst, int& N, int& K) const {
        if (item < n0) loc1(j0, item, step, src, gp, dst, N, K);
        else if (item < n0 + n1) loc1(j1, item - n0, step, src, gp, dst, N, K);
        else loc1(j2, item - n0 - n1, step, src, gp, dst, N, K);
    }
    __device__ __forceinline__ void issue(int item, int step, float (&cv)[R], float& gv, int lane) const {
        const float* src; const float* gp; bf16_t* dst; int N, K; locate(item, step, src, gp, dst, N, K);
        gv = gp ? gp[lane & (R - 1)] : 1.f;
#pragma unroll
        for (int i = 0; i < R; ++i) cv[i] = src[(size_t)i * N + lane];
    }
    __device__ __forceinline__ void finish(int& item, int& step, const float (&cv)[R], float gv, int lane, LAS unsigned char* scr) const {
        const float* src; const float* gp; bf16_t* dst; int N, K; locate(item, 0, src, gp, dst, N, K);
#pragma unroll
        for (int q = 0; q < R / 8; ++q) { u32x4 o;
            o.x = cvt_pk_bf16(cv[8 * q + 0] * rdlane(gv, 8 * q + 0), cv[8 * q + 1] * rdlane(gv, 8 * q + 1)); o.y = cvt_pk_bf16(cv[8 * q + 2] * rdlane(gv, 8 * q + 2), cv[8 * q + 3] * rdlane(gv, 8 * q + 3));
            o.z = cvt_pk_bf16(cv[8 * q + 4] * rdlane(gv, 8 * q + 4), cv[8 * q + 5] * rdlane(gv, 8 * q + 5)); o.w = cvt_pk_bf16(cv[8 * q + 6] * rdlane(gv, 8 * q + 6), cv[8 * q + 7] * rdlane(gv, 8 * q + 7));
            *(LAS u32x4*)(scr + lane * 144 + step * (2 * R) + 16 * q) = o; }
        if (++step == 64 / R) {
            const int r = lane >> 3, cc = lane & 7; bf16_t* d = dst + (size_t)r * K + 8 * cc;
#pragma unroll
            for (int i = 0; i < 8; ++i) { const u32x4 o = *(const LAS u32x4*)(scr + (8 * i + r) * 144 + 16 * cc); __builtin_nontemporal_store(o, (u32x4*)(d + (size_t)(8 * i) * K)); }
            step = 0; item += stride; }
    }
};

__device__ __forceinline__ int rho32(int m) { return (m & 0x13) | ((m & 4) << 1) | ((m & 8) >> 1); }
constexpr int ATT_K0 = 0, ATT_V0 = 32768, ATT_C2 = 65536, ATT_FLAG = 73728;

template <bool FOX>
__device__ __forceinline__ void attn_phase(LAS unsigned char* lds, const bf16_t* qk, int ldqk, int kcol0, int hshift, const bf16_t* vT, const float* c2g, bf16_t* o, int G, int wg, const BgCvt<FOX ? 8 : 16> bg) {
    const int tid = threadIdx.x, lane = tid & 63, w = __builtin_amdgcn_readfirstlane(tid >> 6), n = lane & 31, hi = lane >> 5;
    constexpr int BGR = FOX ? 8 : 16; int bgi = bg.first, bgs = 0;
    float cv[BGR], cgv = 1.f; bool bga = false;
    if constexpr (!FOX) { bga = bg.active(bgi); if (bga) bg.issue(bgi, bgs, cv, cgv, lane); }
    const int krow = tid >> 4, kch = tid & 15, vrow = tid >> 3, vch = tid & 7;
    const int kst0 = krow * 256 + ((kch ^ (krow & 15)) << 4), kst1 = (krow + 32) * 256 + ((kch ^ ((krow + 32) & 15)) << 4);
    const int vst0 = vrow * 128 + ((vch ^ ((vrow >> 1) & 7)) << 4), vst1 = (vrow + 64) * 128 + ((vch ^ (((vrow + 64) >> 1) & 7)) << 4);
    const int rK = rho32(n), kx = rK & 15, vx = (rK >> 1) & 7;
    int koff[8], voff[4];
#pragma unroll
    for (int kk = 0; kk < 8; ++kk) koff[kk] = rK * 256 + (((2 * kk + hi) ^ kx) << 4);
#pragma unroll
    for (int c = 0; c < 4; ++c) voff[c] = rK * 128 + (((2 * c + hi) ^ vx) << 4);

#define ATT_SCHED __builtin_amdgcn_sched_barrier(0)
#define ATT_VLOAD(dst, Vb_, c) do { _Pragma("unroll") for (int d = 0; d < 4; ++d) dst[d] = *(const LAS bf16x8*)((Vb_) + d * 4096 + voff[c]); } while (0)
#define ATT_VMMA(src, P_) do { _Pragma("unroll") for (int d = 0; d < 4; ++d) O[d] = __builtin_amdgcn_mfma_f32_32x32x16_bf16(src[d], (P_), O[d], 0, 0, 0); } while (0)
    bf16x8 qf[8]; u32x4 sk0, sk1, sv0, sv1; int bh_lds = -1;
#define ATT_COORD(uu, bh_, qb_) int bh_ = (uu) & 255; const int qb_ = (uu) >> 8; if (FOX) { const int x_ = bh_ & 7, sl_ = bh_ >> 3, gq_ = sl_ & 3, gi_ = (sl_ >> 2) * 8 + x_; bh_ = (gi_ >> 3) * 32 + (gi_ & 7) * 4 + gq_; }
#define ATT_PREFETCH(uu) do { ATT_COORD(uu, pbh, pqb) const int pb = pbh >> 5, ph = pbh & 31, pkv = ph >> hshift; \
        const bf16_t* qp_ = qk + ((size_t)pb * SEQ + pqb * 256 + 32 * w + n) * ldqk + ph * HD + 8 * hi; \
        _Pragma("unroll") for (int kk = 0; kk < 8; ++kk) qf[kk] = *(const bf16x8*)(qp_ + 16 * kk); \
        const bf16_t* kp_ = qk + ((size_t)pb * SEQ + krow + 64 * (4 * pqb + 3)) * ldqk + kcol0 + pkv * HD + kch * 8; sk0 = *(const u32x4*)kp_; sk1 = *(const u32x4*)(kp_ + (size_t)32 * ldqk); \
        const bf16_t* vp_ = vT + ((size_t)pkv * HD + vrow) * MTOK + (size_t)pb * SEQ + vch * 8 + 64 * (4 * pqb + 3); sv0 = *(const u32x4*)vp_; sv1 = *(const u32x4*)(vp_ + (size_t)64 * MTOK); } while (0)
    auto unit_at = [&](int r) -> int { if (!FOX) { const int uu = wg + G * r; return uu < NB * NH * 8 ? uu : -1; }
        const int v = r * G + ((r & 1) ? G - 1 - wg : wg); return v < NB * NH * 8 ? (((7 - (v >> 8)) << 8) | (v & 255)) : -1; };
    int urnd = 0, u = unit_at(0);
    if (u >= 0) ATT_PREFETCH(u);
    for (; u >= 0; ) {
        const int unext = unit_at(++urnd);
        ATT_COORD(u, bh, qblk)
        const int b = bh >> 5, h = bh & 31, kvh = h >> hshift;
        const int t0 = qblk * 256 + 32 * w, t = t0 + n;
        const size_t tok = (size_t)b * SEQ + t;
        const bf16_t* kg = qk + ((size_t)b * SEQ + krow) * ldqk + kcol0 + kvh * HD + kch * 8;
        const bf16_t* vg = vT + ((size_t)kvh * HD + vrow) * MTOK + (size_t)b * SEQ + vch * 8;
        if (FOX) { if (bh != bh_lds) { *(LAS f32x4*)(lds + ATT_C2 + tid * 16) = *(const f32x4*)(c2g + (size_t)bh * SEQ + tid * 4); bh_lds = bh; } }
        int j = 4 * qblk + 3;
#define ATT_LOAD(jj) do { const bf16_t* kp_ = kg + (size_t)(64 * (jj)) * ldqk; sk0 = *(const u32x4*)kp_; sk1 = *(const u32x4*)(kp_ + (size_t)32 * ldqk); \
        const bf16_t* vp_ = vg + 64 * (jj); sv0 = *(const u32x4*)vp_; sv1 = *(const u32x4*)(vp_ + (size_t)64 * MTOK); } while (0)
#define ATT_STORE(bb) do { *(LAS u32x4*)(lds + ATT_K0 + (bb) * 16384 + kst0) = sk0; *(LAS u32x4*)(lds + ATT_K0 + (bb) * 16384 + kst1) = sk1; \
        *(LAS u32x4*)(lds + ATT_V0 + (bb) * 16384 + vst0) = sv0; *(LAS u32x4*)(lds + ATT_V0 + (bb) * 16384 + vst1) = sv1; } while (0)
        ATT_STORE(0);
        __syncthreads();
        f32x16 O[4];
#pragma unroll
        for (int d = 0; d < 4; ++d)
#pragma unroll
            for (int r = 0; r < 16; ++r) O[d][r] = 0.f;
        float R = FOX ? 0.f : 1.f, m_run = -1e30f, l_run = 0.f;
        int cur = 0;
        const int jw = 4 * qblk + (w >> 1);
        bool wdone = false;
        for (; j >= 0; --j) {
            if (j > 0) ATT_LOAD(j - 1);
            if (j <= jw && !wdone) {
                const LAS unsigned char* Kb = lds + ATT_K0 + cur * 16384;
                const LAS unsigned char* Vb = lds + ATT_V0 + cur * 16384;
                const bool need_mask = (64 * j + 63 >= t0);
                if (!FOX) {
                    bf16x8 ka[4], kc[4], va[4], vb[4];
#define ATT_KLOAD1(dst, kb_, q) do { _Pragma("unroll") for (int i_ = 0; i_ < 4; ++i_) dst[i_] = *(const LAS bf16x8*)(Kb + (kb_) * 8192 + koff[4 * (q) + i_]); } while (0)
#define ATT_KMMA1(src, q) do { _Pragma("unroll") for (int i_ = 0; i_ < 4; ++i_) S = __builtin_amdgcn_mfma_f32_32x32x16_bf16(src[i_], qf[4 * (q) + i_], S, 0, 0, 0); } while (0)
#pragma unroll
                    for (int kb = 1; kb >= 0; --kb) {
                        ATT_KLOAD1(ka, kb, 0); ATT_KLOAD1(kc, kb, 1);
                        f32x16 S;
#pragma unroll
                        for (int r = 0; r < 16; ++r) S[r] = 0.f;
                        ATT_SCHED;
                        ATT_KMMA1(ka, 0); ATT_KMMA1(kc, 1);
                        ATT_SCHED;
                        const int keybase = 64 * j + 32 * kb + 8 * hi;
                        float uu[16], sg[16], E[16], wv[16];
#pragma unroll
                        for (int r = 0; r < 16; ++r) { const float e = __builtin_amdgcn_exp2f(S[r]); const float u1 = __builtin_amdgcn_rcpf(1.f + e); uu[r] = u1; sg[r] = 1.f - u1; }
                        if (need_mask) {
#pragma unroll
                            for (int r = 0; r < 16; ++r) { const int key = keybase + 16 * (r >> 3) + (r & 7); if (key >= t) { uu[r] = 1.f; sg[r] = 0.f; } }
                        }
                        float run = 1.f;
#pragma unroll
                        for (int i = 7; i >= 0; --i) { E[i] = run; run *= uu[i]; }
                        const float tot0 = run; run = 1.f;
#pragma unroll
                        for (int i = 7; i >= 0; --i) { E[8 + i] = run; run *= uu[8 + i]; }
                        const float tot1 = run;
                        const float p0 = __shfl_xor(tot0, 32), p1 = __shfl_xor(tot1, 32);
                        ATT_SCHED;
                        ATT_VLOAD(va, Vb, 2 * kb); ATT_VLOAD(vb, Vb, 2 * kb + 1);
                        ATT_SCHED;
                        const float off1 = hi ? 1.f : p1;
                        const float off0 = tot1 * p1 * (hi ? 1.f : p0);
                        const float b0 = off0 * R, b1 = off1 * R;
#pragma unroll
                        for (int r = 0; r < 16; ++r) wv[r] = sg[r] * E[r] * (r < 8 ? b0 : b1);
                        R *= (tot0 * tot1) * (p0 * p1);
                        union { u32x4 u; bf16x8 v; } pf0, pf1;
                        pf0.u.x = cvt_pk_bf16(wv[0], wv[1]); pf0.u.y = cvt_pk_bf16(wv[2], wv[3]); pf0.u.z = cvt_pk_bf16(wv[4], wv[5]); pf0.u.w = cvt_pk_bf16(wv[6], wv[7]);
                        pf1.u.x = cvt_pk_bf16(wv[8], wv[9]); pf1.u.y = cvt_pk_bf16(wv[10], wv[11]); pf1.u.z = cvt_pk_bf16(wv[12], wv[13]); pf1.u.w = cvt_pk_bf16(wv[14], wv[15]);
                        ATT_SCHED;
                        ATT_VMMA(va, pf0.v); ATT_VMMA(vb, pf1.v);
                        ATT_SCHED;
                    }
#undef ATT_KLOAD1
#undef ATT_KMMA1
                } else {
                    f32x16 S[2];
                    const LAS float* c2s = (const LAS float*)(lds + ATT_C2);
#pragma unroll
                    for (int kb = 0; kb < 2; ++kb)
#pragma unroll
                        for (int a = 0; a < 2; ++a) { const int kbase = 64 * j + 32 * kb + 16 * a + 8 * hi; const f32x4 c0 = *(const LAS f32x4*)(c2s + kbase), c1 = *(const LAS f32x4*)(c2s + kbase + 4);
                            S[kb][8 * a + 0] = c0[0]; S[kb][8 * a + 1] = c0[1]; S[kb][8 * a + 2] = c0[2]; S[kb][8 * a + 3] = c0[3];
                            S[kb][8 * a + 4] = c1[0]; S[kb][8 * a + 5] = c1[1]; S[kb][8 * a + 6] = c1[2]; S[kb][8 * a + 7] = c1[3]; }
                    bf16x8 ka[4], kc[4], va[4], vb[4];
#define ATT_KLOAD2(dst, q) do { dst[0] = *(const LAS bf16x8*)(Kb + koff[2 * (q)]); dst[1] = *(const LAS bf16x8*)(Kb + 8192 + koff[2 * (q)]); \
        dst[2] = *(const LAS bf16x8*)(Kb + koff[2 * (q) + 1]); dst[3] = *(const LAS bf16x8*)(Kb + 8192 + koff[2 * (q) + 1]); } while (0)
#define ATT_KMMA2(src, q) do { S[0] = __builtin_amdgcn_mfma_f32_32x32x16_bf16(src[0], qf[2 * (q)], S[0], 0, 0, 0); S[1] = __builtin_amdgcn_mfma_f32_32x32x16_bf16(src[1], qf[2 * (q)], S[1], 0, 0, 0); \
        S[0] = __builtin_amdgcn_mfma_f32_32x32x16_bf16(src[2], qf[2 * (q) + 1], S[0], 0, 0, 0); S[1] = __builtin_amdgcn_mfma_f32_32x32x16_bf16(src[3], qf[2 * (q) + 1], S[1], 0, 0, 0); } while (0)
                    ATT_KLOAD2(ka, 0); ATT_KLOAD2(kc, 1);
                    ATT_SCHED;

                    ATT_KMMA2(ka, 0); ATT_SCHED; ATT_KLOAD2(ka, 2); ATT_SCHED; ATT_KMMA2(kc, 1); ATT_SCHED; ATT_KLOAD2(kc, 3); ATT_SCHED; ATT_KMMA2(ka, 2); ATT_SCHED;
                    ATT_VLOAD(va, Vb, 0); ATT_VLOAD(vb, Vb, 1);
                    ATT_SCHED; ATT_KMMA2(kc, 3);

                    ATT_SCHED;
#undef ATT_KLOAD2
#undef ATT_KMMA2
                    if (need_mask) {
#pragma unroll
                        for (int kb = 0; kb < 2; ++kb)
#pragma unroll
                            for (int r = 0; r < 16; ++r) { const int key = 64 * j + 32 * kb + 8 * hi + 16 * (r >> 3) + (r & 7); if (key > t) S[kb][r] = -__builtin_inff(); }
                    }
                    float mx = S[0][0];
#pragma unroll
                    for (int kb = 0; kb < 2; ++kb)
#pragma unroll
                        for (int r = 0; r < 16; ++r) mx = __builtin_fmaxf(mx, S[kb][r]);
                    mx = __builtin_fmaxf(mx, __shfl_xor(mx, 32));
                    if (__any(mx > m_run)) {
                        const float m_new = __builtin_fmaxf(m_run, mx); const float alpha = __builtin_amdgcn_exp2f(m_run - m_new);
#pragma unroll
                        for (int d = 0; d < 4; ++d)
#pragma unroll
                            for (int r = 0; r < 16; ++r) O[d][r] *= alpha;
                        l_run *= alpha; m_run = m_new;
                    }
                    float ps = 0.f;
#pragma unroll
                    for (int kb = 0; kb < 2; ++kb)
#pragma unroll
                        for (int r = 0; r < 16; ++r) { S[kb][r] = __builtin_amdgcn_exp2f(S[kb][r] - m_run); ps += S[kb][r]; }
                    l_run += ps;
                    union { u32x4 u; bf16x8 v; } pf[4];
#pragma unroll
                    for (int kb = 0; kb < 2; ++kb)
#pragma unroll
                        for (int ks = 0; ks < 2; ++ks) {
                            pf[2 * kb + ks].u.x = cvt_pk_bf16(S[kb][8 * ks + 0], S[kb][8 * ks + 1]); pf[2 * kb + ks].u.y = cvt_pk_bf16(S[kb][8 * ks + 2], S[kb][8 * ks + 3]);
                            pf[2 * kb + ks].u.z = cvt_pk_bf16(S[kb][8 * ks + 4], S[kb][8 * ks + 5]); pf[2 * kb + ks].u.w = cvt_pk_bf16(S[kb][8 * ks + 6], S[kb][8 * ks + 7]);
                        }
                    ATT_SCHED;

                    ATT_VMMA(va, pf[0].v); ATT_SCHED; ATT_VLOAD(va, Vb, 2); ATT_SCHED; ATT_VMMA(vb, pf[1].v); ATT_SCHED; ATT_VLOAD(vb, Vb, 3); ATT_SCHED; ATT_VMMA(va, pf[2].v); ATT_SCHED; ATT_VMMA(vb, pf[3].v);

                    ATT_SCHED;
                }
            }
            if (!FOX) {
                wdone = wdone || __all(R < 1.17549435e-38f);
                if (lane == 0) *(volatile LAS unsigned*)(lds + ATT_FLAG + 32 * cur + 4 * w) = wdone ? 1u : 0u;
            }
            if constexpr (!FOX) {
                if (bga) bg.finish(bgi, bgs, cv, cgv, lane, lds + BGSCR_OFF + w * 9216);
                bga = bg.active(bgi);
            }
            if (j > 0) ATT_STORE(cur ^ 1);
            if constexpr (!FOX) {
                if (bga) bg.issue(bgi, bgs, cv, cgv, lane);
            }
            __syncthreads();
            if (!FOX) {
                const volatile LAS unsigned* fl = (const volatile LAS unsigned*)(lds + ATT_FLAG + 32 * cur);
                const unsigned alld = fl[0] & fl[1] & fl[2] & fl[3] & fl[4] & fl[5] & fl[6] & fl[7];
                if (alld) break;
            }
            cur ^= 1;
        }
#undef ATT_LOAD
        if (unext >= 0) ATT_PREFETCH(unext);
        float inv = 1.f;
        if (FOX) { const float lt = l_run + __shfl_xor(l_run, 32); inv = 1.f / lt; }
        bf16_t* op = o + tok * DM + h * HD + 8 * hi;
#pragma unroll
        for (int d = 0; d < 4; ++d)
#pragma unroll
            for (int a = 0; a < 2; ++a) { u32x4 wv4;
                wv4.x = cvt_pk_bf16(O[d][8 * a + 0] * inv, O[d][8 * a + 1] * inv); wv4.y = cvt_pk_bf16(O[d][8 * a + 2] * inv, O[d][8 * a + 3] * inv);
                wv4.z = cvt_pk_bf16(O[d][8 * a + 4] * inv, O[d][8 * a + 5] * inv); wv4.w = cvt_pk_bf16(O[d][8 * a + 6] * inv, O[d][8 * a + 7] * inv);
                *(u32x4*)(op + 32 * d + 16 * a) = wv4; }
        u = unext;
    }
#undef ATT_STORE
#undef ATT_SCHED
#undef ATT_VLOAD
#undef ATT_VMMA
#undef ATT_COORD
#undef ATT_PREFETCH
    if constexpr (!FOX) {
        while (bga) { bg.finish(bgi, bgs, cv, cgv, lane, lds + BGSCR_OFF + w * 9216); bga = bg.active(bgi); if (bga) bg.issue(bgi, bgs, cv, cgv, lane); } }
}

__device__ __forceinline__ void flogit_phase(LAS unsigned char* lds, const bf16_t* hb, const bf16_t* wf_t, const float* rstd, const float* b_f, float* flog, int G, int wg) {
    const int tid = threadIdx.x, lane = tid & 63, w = __builtin_amdgcn_readfirstlane(tid >> 6), n = lane & 31, hi = lane >> 5;
    const int rsub = w & 1, kq = w >> 1;
    LAS float* red = (LAS float*)lds;
    for (int rb = wg; rb < MTOK / 64; rb += G) {
        const int row0 = rb * 64 + rsub * 32;
        const bf16_t* ap = hb + (size_t)(row0 + n) * DM + kq * 1024 + 32 * hi;
        const bf16_t* bp = wf_t + (size_t)n * DM + kq * 1024 + 32 * hi;
        f32x16 acc;
#pragma unroll
        for (int r = 0; r < 16; ++r) acc[r] = 0.f;
#pragma unroll 2
        for (int g = 0; g < 16; ++g) {
            bf16x8 a[4], bb[4];
#pragma unroll
            for (int i = 0; i < 4; ++i) { a[i] = *(const bf16x8*)(ap + g * 64 + 8 * i); bb[i] = *(const bf16x8*)(bp + g * 64 + 8 * i); }
#pragma unroll
            for (int i = 0; i < 4; ++i) acc = __builtin_amdgcn_mfma_f32_32x32x16_bf16(a[i], bb[i], acc, 0, 0, 0);
        }
#pragma unroll
        for (int r = 0; r < 16; ++r) red[(w * 16 + r) * 64 + lane] = acc[r];
        __syncthreads();
        if (kq == 0) {
            const float bias = b_f[n];
#pragma unroll
            for (int r = 0; r < 16; ++r) {
                float s = 0.f;
#pragma unroll
                for (int q = 0; q < 4; ++q) s += red[((q * 2 + rsub) * 16 + r) * 64 + lane];
                const int row = row0 + (r & 3) + 8 * (r >> 2) + 4 * hi;
                const float v = rstd[row] * s + bias;
                const float ls = __builtin_fminf(v, 0.f) - log1pf(__expf(-__builtin_fabsf(v)));
                flog[(size_t)row * NH + n] = ls;
            }
        }
        __syncthreads();
    }
}
__device__ __forceinline__ void cumsum_phase(LAS unsigned char* lds, const float* flog, float* c2, int G, int wg) {
    const int tid = threadIdx.x, lane = tid & 63, w = tid >> 6;
    LAS float* wt = (LAS float*)lds;
    for (int bh = wg; bh < NB * NH; bh += G) {
        const int b = bh >> 5, h = bh & 31;
        float v[4];
#pragma unroll
        for (int k = 0; k < 4; ++k) v[k] = flog[((size_t)b * SEQ + 4 * tid + k) * NH + h];
        v[1] += v[0]; v[2] += v[1]; v[3] += v[2];
        float s = v[3];
#pragma unroll
        for (int o = 1; o < 64; o <<= 1) { const float tv = __shfl_up(s, o); if (lane >= o) s += tv; }
        if (lane == 63) wt[w] = s;
        __syncthreads();
        float base = s - v[3];
        for (int i = 0; i < w; ++i) base += wt[i];
        f32x4 ov; ov[0] = (base + v[0]) * -LOG2E; ov[1] = (base + v[1]) * -LOG2E; ov[2] = (base + v[2]) * -LOG2E; ov[3] = (base + v[3]) * -LOG2E;
        *(f32x4*)(c2 + (size_t)bh * SEQ + 4 * tid) = ov;
        __syncthreads();
    }
}

__device__ __forceinline__ void unpack8(const u32x4 p, float (&f)[8]) {
    f[0] = __uint_as_float(p.x << 16); f[1] = __uint_as_float(p.x & 0xffff0000u); f[2] = __uint_as_float(p.y << 16); f[3] = __uint_as_float(p.y & 0xffff0000u);
    f[4] = __uint_as_float(p.z << 16); f[5] = __uint_as_float(p.z & 0xffff0000u); f[6] = __uint_as_float(p.w << 16); f[7] = __uint_as_float(p.w & 0xffff0000u);
}
__device__ __forceinline__ void convfix_phase(const float* glast, const float* pfirst, const float* vfirst, const float* wconv, bf16_t* act, int G, int wg) {
    constexpr int NCG = FF / 8, NBLK = MTOK / 64, NTASK = NBLK * NCG;
    const int gt = wg * (NWAVES * 64) + threadIdx.x, stride = G * NWAVES * 64;
    for (int task = gt; task < NTASK; task += stride) {
        const int blk = task / NCG, cg = task - blk * NCG, f0 = cg * 8;
        if ((blk & (SEQ / 64 - 1)) == 0) continue;
        const float* g0p = glast + ((size_t)(blk - 1) * 2 + 0) * FF + f0; const float* g1p = g0p + FF;
        const float* p0p = pfirst + ((size_t)blk * 2 + 0) * FF + f0; const float* p1p = p0p + FF;
        const float* v0p = vfirst + ((size_t)blk * 2 + 0) * FF + f0; const float* v1p = v0p + FF;
        float y0[8], y1[8];
#pragma unroll
        for (int q = 0; q < 2; ++q) {
            const f32x4 w0 = *(const f32x4*)(wconv + f0 + 4 * q), w1 = *(const f32x4*)(wconv + FF + f0 + 4 * q);
            const f32x4 G0 = *(const f32x4*)(g0p + 4 * q), G1 = *(const f32x4*)(g1p + 4 * q), P0 = *(const f32x4*)(p0p + 4 * q), P1 = *(const f32x4*)(p1p + 4 * q), V0 = *(const f32x4*)(v0p + 4 * q), V1 = *(const f32x4*)(v1p + 4 * q);
#pragma unroll
            for (int i = 0; i < 4; ++i) { const float c0 = P0[i] + w0[i] * G0[i] + w1[i] * G1[i], c1 = P1[i] + w0[i] * G1[i];
                y0[4 * q + i] = c0 / (1.f + __expf(-c0)) * V0[i]; y1[4 * q + i] = c1 / (1.f + __expf(-c1)) * V1[i]; }
        }
        u32x4 o0, o1; o0.x = cvt_pk_bf16(y0[0], y0[1]); o0.y = cvt_pk_bf16(y0[2], y0[3]); o0.z = cvt_pk_bf16(y0[4], y0[5]); o0.w = cvt_pk_bf16(y0[6], y0[7]);
        o1.x = cvt_pk_bf16(y1[0], y1[1]); o1.y = cvt_pk_bf16(y1[2], y1[3]); o1.z = cvt_pk_bf16(y1[4], y1[5]); o1.w = cvt_pk_bf16(y1[6], y1[7]);
        *(u32x4*)(act + (size_t)(blk * 64) * FF + f0) = o0; *(u32x4*)(act + (size_t)(blk * 64 + 1) * FF + f0) = o1;
    }
}

struct Args { const float* in[22]; float* out; unsigned char* ws; int ph_lo, ph_hi; };
__global__ void __launch_bounds__(NWAVES * 64, 2) yoco_fwd(Args args) {
    extern __shared__ __attribute__((aligned(16))) unsigned char lds_raw[];
    LAS unsigned char* lds = (LAS unsigned char*)lds_raw;
    volatile LAS unsigned* MISC = (volatile LAS unsigned*)(lds + MISC_OFF);
    const int tid = threadIdx.x, lane = tid & 63, wave = __builtin_amdgcn_readfirstlane(tid >> 6);
    const int G = gridDim.x, wg = blockIdx.x;
    const int gw = wg * NWAVES + wave, NGW = G * NWAVES;
    unsigned char* ws = args.ws;
    for (int u = tid; u < (LDS_BYTES - LDSCTL_OFF) / 4; u += NWAVES * 64) ((LAS unsigned*)(lds + LDSCTL_OFF))[u] = 0u;
    __syncthreads();
    XcdBarrier bar; bar.bar = g_ctl; bar.x = 0; bar.st = nullptr;
    if (MK_N_LAUNCHES == 1) bar = xcd_barrier_post(g_ctl, MISC + 8);
    const int lo = args.ph_lo, hi = args.ph_hi;
#define IN(k) (lo <= (k) && (k) < hi)
#define SEAM(k) do { if (MK_N_LAUNCHES == 1 && IN(k) && IN((k) + 1)) xcd_barrier(bar); } while (0)

    float* hres = args.out;
    float* rstdA = (float*)(ws + WS_RSTDA);
    bf16_t* wf_t = (bf16_t*)(ws + WS_WF); float* flog = (float*)(ws + WS_FLOG); float* c2 = (float*)(ws + WS_C2); float* part = (float*)(ws + WS_PART);
    bf16_t* Wqkv_t = (bf16_t*)(ws + WS_W + W_QKV); bf16_t* Wo_t = (bf16_t*)(ws + WS_W + W_O); bf16_t* Wup_t = (bf16_t*)(ws + WS_W + W_UP); bf16_t* Wdown_t = (bf16_t*)(ws + WS_W + W_DOWN);
    bf16_t* hb = (bf16_t*)(ws + WS_HB); bf16_t* qkb = (bf16_t*)(ws + WS_R + R_QK); bf16_t* vTb = (bf16_t*)(ws + WS_R + R_VT); bf16_t* ob = (bf16_t*)(ws + WS_R + R_O);
    const CvtJob jB0{args.in[14], args.in[13], Wqkv_t, DM, DM, 0}, jB1{args.in[10], args.in[9], Wqkv_t + (size_t)DM * DM, DM, 2048, 0}, jB2{args.in[15], nullptr, Wo_t, DM, DM, 0},
                 jB3{args.in[17], args.in[16], Wup_t, DM, FF2, 1}, jB4{args.in[20], nullptr, Wdown_t, FF, DM, 0};
    constexpr int nB0 = CVT_NITEMS(DM, DM), nB1 = CVT_NITEMS(DM, 2048), nB2 = CVT_NITEMS(DM, DM), nB3 = CVT_NITEMS(DM, FF2), nB4 = CVT_NITEMS(FF, DM), nBd = nB2 + nB3 + nB4;
    const int conv_wgs = (G >= 128 && G % 8 == 0) ? CONV_WGS : 0, conv_d3 = conv_wgs ? CONV_D3 : 0;
    const int conv_wgs_unused_ = 0;
    bf16_t* actb = (bf16_t*)(ws + WS_ACT); float* glast = (float*)(ws + WS_SIDE); float* pfirst = (float*)(ws + WS_SIDE + SIDE_ONE); float* vfirst = (float*)(ws + WS_SIDE + 2 * SIDE_ONE);

    auto layer = [&](auto LC) __attribute__((always_inline)) {
        constexpr int l = decltype(LC)::value;
        constexpr int P = 9 * l;
        constexpr int nkv = l ? 1024 : 4096;
        if (IN(P + 0)) {
            LAS unsigned char* cscr = lds + wave * 18432;
            if (l == 0) {
                const CvtJob j0{args.in[2], args.in[1], Wqkv_t, DM, 3 * DM, 0};
                CVT_PIPE1(j0, gw, CVT_NITEMS(DM, 3 * DM), NGW, cscr);
            } else {
                CVT_WINDOW(jB0, 0, nB0, 0, nB0 + nB1 + nB2, gw, NGW, cscr); CVT_WINDOW(jB1, nB0, nB1, 0, nB0 + nB1 + nB2, gw, NGW, cscr); CVT_WINDOW(jB2, nB0 + nB1, nB2, 0, nB0 + nB1 + nB2, gw, NGW, cscr);
                { constexpr int m3 = CVT_NITEMS2(DM, FF2), m4 = CVT_NITEMS2(FF, DM);
                  for (int it = conv_d3 + gw; it < m3 + (conv_wgs ? 0 : m4); it += NGW) {
                      if (it < m3) { cvt_item2(jB3, it, lane, lds + wave * 18432); asm volatile("; job B3"); } else { cvt_item2(jB4, it - m3, lane, lds + wave * 18432); asm volatile("; job B4"); } } }
            }
            if (l == 0) {
                const float* x = args.in[0];
                for (int m = gw; m < MTOK; m += NGW) {
                    const f32x4* xr = (const f32x4*)(x + (size_t)m * DM) + lane; f32x4 v[16]; float s = 0.f;
#pragma unroll
                    for (int j = 0; j < 16; ++j) { v[j] = xr[64 * j]; s += (v[j][0] * v[j][0] + v[j][1] * v[j][1]) + (v[j][2] * v[j][2] + v[j][3] * v[j][3]); }
                    s = wave_sum(s);
                    if (lane == 0) rstdA[m] = 1.f / sqrtf(s * (1.f / DM) + RMS_EPS);
                    u32x2* o8 = (u32x2*)(hb + (size_t)m * DM) + lane;
#pragma unroll
                    for (int j = 0; j < 16; ++j) { u32x2 p; p.x = cvt_pk_bf16(v[j][0], v[j][1]); p.y = cvt_pk_bf16(v[j][2], v[j][3]); o8[64 * j] = p; }
                }
            } else {
                const float* wf = args.in[11]; const float* gk = args.in[9];
                for (int i = wg * NWAVES * 64 + tid; i < NH * DM; i += G * NWAVES * 64) { const int hh = i / DM, k = i - hh * DM; wf_t[i] = (bf16_t)(cvt_pk_bf16(wf[(size_t)k * NH + hh] * gk[k], 0.f) & 0xffffu); }
                for (int r = wg * NWAVES * 64 + tid; r < MTOK; r += G * NWAVES * 64) { const f32x4* pp = (const f32x4*)(part + (size_t)r * 64); float s = 0.f;
#pragma unroll
                    for (int j = 0; j < 16; ++j) { const f32x4 q = pp[j]; s += (q[0] + q[1]) + (q[2] + q[3]); }
                    rstdA[r] = 1.f / sqrtf(s * (1.f / DM) + RMS_EPS); }
            }
        }
        SEAM(P + 0);
        if (IN(P + 1)) {
            { pg8::Gemm g{hb, Wqkv_t, MTOK, DM + nkv, DM}; pg8::FixedOrder S; S.init(MTOK, DM + nkv, G, wg);
              pg8::EpiRowScale E{qkb, DM + nkv, make_rowscale(lds, S, rstdA, nullptr), DM / 256, QSCALE};
              pg8::gemm_phase<pg8::EpiRowScale, pg8::FixedOrder, PG8_ALIGN, PG8_SP2>(lds, g, S, E); }
            { pg8::Gemm g{Wqkv_t + (size_t)(DM + nkv) * DM, hb, nkv, MTOK, DM}; pg8::StaticOrder S; S.init(nkv, MTOK, G, wg);
              pg8::EpiColScale E{vTb, MTOK, rstdA};
              pg8::gemm_phase<pg8::EpiColScale, pg8::StaticOrder, PG8_ALIGN, PG8_SP2>(lds, g, S, E); }
            if (l == 1) flogit_phase(lds, hb, wf_t, rstdA, args.in[12], flog, G, wg);
        }
        SEAM(P + 1);
        if (l == 1) { if (IN(P + 2)) cumsum_phase(lds, flog, c2, G, wg); SEAM(P + 2); }
        if (IN(P + 3)) {
            const BgCvt<l ? 8 : 16> bg{CvtJob{args.in[l ? 15 : 3], nullptr, Wo_t, DM, DM, 0}, CvtJob{args.in[l ? 17 : 5], args.in[l ? 16 : 4], Wup_t, DM, FF2, 1}, CvtJob{args.in[l ? 20 : 8], nullptr, Wdown_t, FF, DM, 0},
                     l ? 0 : CVT_NITEMS(DM, DM), l ? 0 : CVT_NITEMS(DM, FF2), l ? 0 : CVT_NITEMS(FF, DM), gw, NGW};
            if constexpr (l == 0) attn_phase<false>(lds, qkb, 2 * DM, DM, 0, vTb, nullptr, ob, G, wg, bg);
            else if (wg < G - conv_wgs) attn_phase<true>(lds, qkb, DM + 1024, DM, 2, vTb, c2, ob, G - conv_wgs, wg, bg);
            else { LAS unsigned char* cscr = lds + wave * 18432; const int cw = (wg - (G - conv_wgs)) * NWAVES + wave, T = conv_wgs * NWAVES;
                   constexpr int m4 = CVT_NITEMS2(FF, DM);
                   for (int it = cw; it < conv_d3 + m4; it += T) {
                       if (it < conv_d3) { cvt_item2(jB3, it, lane, cscr); asm volatile("; job B3"); } else { cvt_item2(jB4, it - conv_d3, lane, cscr); asm volatile("; job B4"); }
                   } }
        }
        SEAM(P + 3);
        if (IN(P + 4)) {
            pg8::Gemm g{ob, Wo_t, MTOK, DM, DM}; pg8::StaticOrder S; S.init(MTOK, DM, G, wg);
            pg8::EpiResid E{hb, part, DM};
            pg8::gemm_phase<pg8::EpiResid, pg8::StaticOrder, PG8_ALIGN, PG8_SP2>(lds, g, S, E);
        }
        SEAM(P + 4);
        if (IN(P + 6)) {
            pg8::Gemm g{hb, Wup_t, MTOK, FF2, DM}; pg8::FixedOrder S; S.init(MTOK, FF2, G, wg);
            pg8::EpiGlu E{actb, make_rowscale(lds, S, nullptr, part), args.in[l ? 18 : 6], args.in[l ? 19 : 7], glast, pfirst, vfirst};
            pg8::gemm_phase<pg8::EpiGlu, pg8::FixedOrder, PG8_ALIGN, PG8_SP2>(lds, g, S, E);
        }
        SEAM(P + 6);
        if (IN(P + 7)) convfix_phase(glast, pfirst, vfirst, args.in[l ? 18 : 6], actb, G, wg);
        SEAM(P + 7);
        if (IN(P + 8)) {
            pg8::Gemm g{actb, Wdown_t, MTOK, DM, FF}; pg8::StaticOrder S; S.init(MTOK, DM, G, wg, 4);
            pg8::EpiResid E{hb, part, DM};
            pg8::gemm_phase<pg8::EpiResid, pg8::StaticOrder, PG8_ALIGN, PG8_SP2>(lds, g, S, E);
        }
        SEAM(P + 8);
    };
    layer(std::integral_constant<int, 0>{});
    layer(std::integral_constant<int, 1>{});
    if (IN(18)) {
        const float* gfin = args.in[21];
        for (int m = gw; m < MTOK; m += NGW) {
            const u32x4* xr = (const u32x4*)(hb + (size_t)m * DM) + lane; float v[8][8]; float s = 0.f;
#pragma unroll
            for (int j = 0; j < 8; ++j) { unpack8(xr[64 * j], v[j]);
#pragma unroll
                for (int i = 0; i < 8; ++i) s += v[j][i] * v[j][i]; }
            s = wave_sum(s);
            const float rs = 1.f / sqrtf(s * (1.f / DM) + RMS_EPS);
            float* orow = hres + (size_t)m * DM;
#pragma unroll
            for (int j = 0; j < 8; ++j) { const int c0 = 8 * (lane + 64 * j); const f32x4 g0 = *(const f32x4*)(gfin + c0), g1 = *(const f32x4*)(gfin + c0 + 4);
                *(f32x4*)(orow + c0) = (f32x4){v[j][0] * rs * g0[0], v[j][1] * rs * g0[1], v[j][2] * rs * g0[2], v[j][3] * rs * g0[3]};
                *(f32x4*)(orow + c0 + 4) = (f32x4){v[j][4] * rs * g1[0], v[j][5] * rs * g1[1], v[j][6] * rs * g1[2], v[j][7] * rs * g1[3]}; }
        }
    }
#undef IN
#undef SEAM
    if (MK_N_LAUNCHES == 1) {
        __syncthreads();
        if (tid == 0) MISC[16] = (xb_add(&g_ctl[XB_EXIT], 1u) == (unsigned)G - 1u) ? 1u : 0u;
        __syncthreads();
        if (MISC[16]) for (int i = tid; i < XCD_BAR_WORDS + 64; i += NWAVES * 64) g_ctl[i] = 0u;
    }
}

extern "C" void kernel_launch(void* const* d_in, const int* in_sizes, int n_in, void* d_out, int out_size, void* d_ws, size_t ws_size, hipStream_t stream) {
    static int grid = 0;
    if (grid == 0) {
        if (n_in != 22 || out_size != MTOK * DM || ws_size < WS_END) { fprintf(stderr, "kernel_launch: unexpected shapes (n_in %d out %d ws %zu need %zu)\n", n_in, out_size, ws_size, (size_t)WS_END); grid = -1; return; }
        int dev = 0, cus = 0, per_cu = 0;
        if (hipGetDevice(&dev) != hipSuccess || hipDeviceGetAttribute(&cus, hipDeviceAttributeMultiprocessorCount, dev) != hipSuccess) { grid = -1; return; }
        if (hipFuncSetAttribute((const void*)yoco_fwd, hipFuncAttributeMaxDynamicSharedMemorySize, LDS_BYTES) != hipSuccess) { fprintf(stderr, "kernel_launch: hipFuncSetAttribute failed\n"); grid = -1; return; }
        if (hipOccupancyMaxActiveBlocksPerMultiprocessor(&per_cu, (const void*)yoco_fwd, NWAVES * 64, LDS_BYTES) != hipSuccess || per_cu < 1) { fprintf(stderr, "kernel_launch: occupancy query says %d blocks per CU\n", per_cu); }
        (void)hipGetLastError();
        grid = cus;
        if (grid % 8 != 0 || grid < 64) { fprintf(stderr, "kernel_launch: %d CUs: the row-panel order needs a multiple of 8 and at least 64 workgroups\n", grid); grid = -1; return; }
    }
    if (grid < 0) return;
    (void)in_sizes;
    Args a{};
    for (int i = 0; i < 22; ++i) a.in[i] = (const float*)d_in[i];
    a.out = (float*)d_out; a.ws = (unsigned char*)d_ws;
    if (MK_N_LAUNCHES == 1) {
        a.ph_lo = 0; a.ph_hi = N_PHASES;
        hipLaunchKernelGGL(yoco_fwd, dim3(grid), dim3(NWAVES * 64), LDS_BYTES, stream, a);
    } else {
        for (int p = 0; p < N_PHASES; ++p) {
            if (p == 2) continue;
            a.ph_lo = p; a.ph_hi = p + 1;
            hipLaunchKernelGGL(yoco_fwd, dim3(grid), dim3(NWAVES * 64), LDS_BYTES, stream, a);
        }
    }
    const hipError_t le = hipPeekAtLastError();
    if (le != hipSuccess) fprintf(stderr, "kernel_launch: launch failed: %s\n", hipGetErrorName(le));
}
```
